# Optimizing an MI355X kernel written in HIP

```python
import math
import jax, jax.numpy as jnp
from jax import lax
import numpy as np

D_MODEL = 1024
BATCH = 16
SEQ = 4096
DEPTH = 4

N_MIXERS = 3
D_FF = 4 * D_MODEL
DEEPNORM_ALPHA = (2.0 * DEPTH) ** 0.25
DEEPNORM_BETA = (8.0 * DEPTH) ** -0.25
LN_EPS = 1e-5

A_CHUNK = 128
A_WIDTH = D_MODEL
A_GROUPS = 8
A_GROUP_DIM = A_WIDTH // A_GROUPS

B_GROUPS = 4
B_GROUP_DIM = D_MODEL // B_GROUPS

POOL_WINDOWS = (2, 4, 8, 16)
C_GROUPS = len(POOL_WINDOWS)
C_GROUP_DIM = D_MODEL // C_GROUPS

N_A = (DEPTH + 2) // 3
N_B = (DEPTH + 1) // 3
N_C = DEPTH // 3

kernel_name = "hybrid_gmlp_fnet_pool_deepnorm_encoder"


def _layer_norm(x, g, b):
    xf = x.astype(jnp.float32)
    mu = jnp.mean(xf, axis=-1, keepdims=True)
    var = jnp.mean(jnp.square(xf - mu), axis=-1, keepdims=True)
    return ((xf - mu) * lax.rsqrt(var + LN_EPS) * g + b).astype(x.dtype)


def _centred_window_mean(z, w):
    b, s, c = z.shape
    zf = z.astype(jnp.float32)
    cs = jnp.concatenate([jnp.zeros((b, 1, c), jnp.float32), jnp.cumsum(zf, axis=1)], axis=1)
    t = jnp.arange(s)
    lo = jnp.clip(t - w // 2, 0, s)
    hi = jnp.clip(t - w // 2 + w, 0, s)
    window_sum = jnp.take(cs, hi, axis=1) - jnp.take(cs, lo, axis=1)
    count = (hi - lo).astype(jnp.float32)[None, :, None]
    return (window_sum / count).astype(z.dtype)


def spatial_gating_mixer(x, w_in, ln_g, ln_b, w_s, b_s, w_out):
    bsz, s, _ = x.shape
    z = jax.nn.gelu(x @ w_in)
    u, v = jnp.split(z, 2, axis=-1)
    v = _layer_norm(v, ln_g, ln_b)
    v = v.reshape(bsz, s // A_CHUNK, A_CHUNK, A_GROUPS, A_GROUP_DIM)
    mixed = jnp.einsum('gqp,bnpgd->bnqgd', w_s, v) + b_s.T[None, None, :, :, None]
    out = u * mixed.reshape(bsz, s, A_WIDTH)
    return out @ w_out


def fourier_mixer(x, w_in, ln_g, ln_b, w_out):
    bsz, s, _ = x.shape
    z = (x @ w_in).reshape(bsz, s, B_GROUPS, B_GROUP_DIM)
    z = _layer_norm(z, ln_g, ln_b)
    f = jnp.fft.fft2(z.astype(jnp.float32), axes=(1, 3), norm="ortho").real
    return f.astype(x.dtype).reshape(bsz, s, D_MODEL) @ w_out


def multiscale_pool_mixer(x, w_in, w_grp, scale, w_out):
    bsz, s, _ = x.shape
    z = (x @ w_in).reshape(bsz, s, C_GROUPS, C_GROUP_DIM)
    pooled = jnp.stack(
        [_centred_window_mean(z[:, :, g], w) - z[:, :, g] for g, w in enumerate(POOL_WINDOWS)],
        axis=2)
    mixed = jnp.einsum('bsgc,gcd->bsgd', pooled, w_grp).reshape(bsz, s, D_MODEL) * scale
    return mixed @ w_out


def squared_relu_mlp(x, w1, b1, w2, b2):
    h = jnp.square(jax.nn.relu(x @ w1 + b1))
    return h @ w2 + b2


def setup_inputs(seed: int = 0) -> dict:
    key = jax.random.key(seed)
    ks = iter(jax.random.split(key, 32))

    def normal(shape, scale):
        return jax.random.normal(next(ks), shape, jnp.float32) * scale

    def gain(shape):
        return 1.0 + normal(shape, 0.05)

    d, f = D_MODEL, D_FF
    return {
        "x": normal((BATCH, SEQ, d), 1.0),
        "ln1_g": gain((DEPTH, d)),
        "ln1_b": normal((DEPTH, d), 0.02),
        "ffn_w1": normal((DEPTH, d, f), d ** -0.5),
        "ffn_b1": normal((DEPTH, f), 0.02),
        "ffn_w2": normal((DEPTH, f, d), DEEPNORM_BETA * f ** -0.5),
        "ffn_b2": normal((DEPTH, d), 0.02),
        "ln2_g": gain((DEPTH, d)),
        "ln2_b": normal((DEPTH, d), 0.02),
        "a_w_in": normal((N_A, d, 2 * A_WIDTH), d ** -0.5),
        "a_ln_g": gain((N_A, A_WIDTH)),
        "a_ln_b": normal((N_A, A_WIDTH), 0.02),
        "a_w_s": normal((N_A, A_GROUPS, A_CHUNK, A_CHUNK), A_CHUNK ** -0.5),
        "a_b_s": gain((N_A, A_GROUPS, A_CHUNK)),
        "a_w_out": normal((N_A, A_WIDTH, d), DEEPNORM_BETA * A_WIDTH ** -0.5),
        "b_w_in": normal((N_B, d, d), d ** -0.5),
        "b_ln_g": gain((N_B, B_GROUPS, B_GROUP_DIM)),
        "b_ln_b": normal((N_B, B_GROUPS, B_GROUP_DIM), 0.02),
        "b_w_out": normal((N_B, d, d), DEEPNORM_BETA * d ** -0.5),
        "c_w_in": normal((N_C, d, d), d ** -0.5),
        "c_w_grp": normal((N_C, C_GROUPS, C_GROUP_DIM, C_GROUP_DIM), C_GROUP_DIM ** -0.5),
        "c_scale": gain((N_C, d)),
        "c_w_out": normal((N_C, d, d), DEEPNORM_BETA * d ** -0.5),
    }


def reference(x, ln1_g, ln1_b, ffn_w1, ffn_b1, ffn_w2, ffn_b2, ln2_g, ln2_b,
              a_w_in, a_ln_g, a_ln_b, a_w_s, a_b_s, a_w_out,
              b_w_in, b_ln_g, b_ln_b, b_w_out,
              c_w_in, c_w_grp, c_scale, c_w_out):
    for i in range(DEPTH):
        kind, j = i % N_MIXERS, i // N_MIXERS
        if kind == 0:
            y = spatial_gating_mixer(x, a_w_in[j], a_ln_g[j], a_ln_b[j], a_w_s[j], a_b_s[j], a_w_out[j])
        elif kind == 1:
            y = fourier_mixer(x, b_w_in[j], b_ln_g[j], b_ln_b[j], b_w_out[j])
        else:
            y = multiscale_pool_mixer(x, c_w_in[j], c_w_grp[j], c_scale[j], c_w_out[j])
        x = _layer_norm(DEEPNORM_ALPHA * x + y, ln1_g[i], ln1_b[i])
        y = squared_relu_mlp(x, ffn_w1[i], ffn_b1[i], ffn_w2[i], ffn_b2[i])
        x = _layer_norm(DEEPNORM_ALPHA * x + y, ln2_g[i], ln2_b[i])
    return x
```

```cpp
#include <hip/hip_runtime.h>
#include <hip/hip_cooperative_groups.h>
#include <cstdio>
namespace cg = cooperative_groups;

#define LAS __attribute__((address_space(3)))
typedef unsigned short bf16_t;
typedef short bf16x8 __attribute__((ext_vector_type(8)));
typedef float f32x4 __attribute__((ext_vector_type(4)));
typedef float f32x2 __attribute__((ext_vector_type(2)));
typedef unsigned u32x4 __attribute__((ext_vector_type(4)));
typedef unsigned u32x2 __attribute__((ext_vector_type(2)));

constexpr int MT = 65536, DM = 1024, FF = 4096, SEQ = 4096;
constexpr float ALPHA = 1.681792830507429f;
constexpr float LN_EPS = 1e-5f;
constexpr int NTHREADS = 512;
constexpr int LDS_STAGE = 131072;
constexpr int LDS_SPF = LDS_STAGE + 8256 + 2048;
constexpr int LDS_VEC = LDS_SPF + 8192;
constexpr int LDS_BYTES = LDS_VEC + 3072;
#ifndef FFN_NCH
#define FFN_NCH 4
#endif
#ifndef PHMASK
#define PHMASK 0xffffffffu
#endif

constexpr size_t MB128 = 134217728ull;
constexpr size_t WS_H = 0;
constexpr size_t WS_T1 = 4 * MB128;
constexpr size_t WS_T2 = 5 * MB128;
constexpr size_t WS_W = 6 * MB128;
constexpr size_t W_W1T = WS_W;
constexpr size_t W_W2T = W_W1T + 33554432ull;
constexpr size_t W_AWIN = W_W2T + 33554432ull;
constexpr size_t W_AWOUT = W_AWIN + 8388608ull;
constexpr size_t W_AWS = W_AWOUT + 4194304ull;
constexpr size_t W_BWIN = W_AWS + 524288ull;
constexpr size_t W_BWOUT = W_BWIN + 2097152ull;
constexpr size_t W_CWIN = W_BWOUT + 2097152ull;
constexpr size_t W_CWOUT = W_CWIN + 2097152ull;
constexpr size_t W_CWG = W_CWOUT + 2097152ull;
constexpr size_t W_WCD = W_CWG + 524288ull;
constexpr size_t W_DSEQ = W_WCD + 1048576ull;
constexpr size_t WS_VEC = W_DSEQ + 67108864ull;
constexpr size_t V_C1FFN = WS_VEC;
constexpr size_t V_CBFFN = V_C1FFN + 65536;
constexpr size_t V_C1MIX = V_CBFFN + 65536;
constexpr size_t V_CBMIX = V_C1MIX + 32768;
constexpr size_t V_C1CD = V_CBMIX + 32768;
constexpr size_t V_C2CD = V_C1CD + 8192;
constexpr size_t V_WSROW = V_C2CD + 8192;
constexpr size_t V_SIDE0 = V_WSROW + 8192;
constexpr size_t WS_ST1 = V_SIDE0 + 65536;
constexpr size_t WS_ST2 = WS_ST1 + 8388608ull;
constexpr size_t WS_STV = WS_ST2 + 8388608ull;
constexpr size_t WS_BAR = WS_STV + 8388608ull;
constexpr size_t WS_CNT = WS_BAR + 16384;
constexpr size_t WS_XBUF = WS_CNT + 65536;
constexpr size_t WS_END = WS_XBUF + 2097152ull;

struct Params { const float* in[23]; float* out; unsigned char* ws; int coop; int pad; };

constexpr int BM = 256, BK = 64, HALF = 128, HTB = HALF * BK * 2, NXCD = 8, WGM = 8;
__device__ __forceinline__ unsigned pk2(float lo, float hi) { unsigned r; asm("v_cvt_pk_bf16_f32 %0, %1, %2" : "=v"(r) : "v"(lo), "v"(hi)); return r; }
__device__ __forceinline__ float bf_lo(unsigned w) { return __uint_as_float(w << 16); }
__device__ __forceinline__ float bf_hi(unsigned w) { return __uint_as_float(w & 0xffff0000u); }
__device__ __forceinline__ float bf_round(float x) { unsigned u = __float_as_uint(x); u += 0x7fffu + ((u >> 16) & 1u); return __uint_as_float(u & 0xffff0000u); }
__device__ __forceinline__ float shx(float v, int lane, int o) { return __int_as_float(__builtin_amdgcn_ds_bpermute((lane ^ o) << 2, __float_as_int(v))); }
__device__ __forceinline__ float wave_sum(float v, int lane) {
#pragma unroll
    for (int o = 1; o < 64; o <<= 1) v += shx(v, lane, o);
    return v;
}
__device__ __forceinline__ float gelu_tanh(float x) {
    const float t = x * (1.0f + 0.044715f * x * x);
    const float e = __builtin_amdgcn_exp2f(-2.302208198f * t);
    return x * __builtin_amdgcn_rcpf(1.0f + e);
}
#define UP(T, base, ub, lb) ((T*)((const char*)(base) + (size_t)(ub) + (unsigned)(lb)))
__device__ __forceinline__ void row_stats4(const float* ST, int urow, int fr, int fq, float& mu, float& rstd) {
    const f32x2 a = *UP(const f32x2, ST, (size_t)urow * 32, fr * 32 + fq * 8);
    float s = a.x, q = a.y;
    const int ln = fq * 16 + fr;
    s += shx(s, ln, 16); s += shx(s, ln, 32); q += shx(q, ln, 16); q += shx(q, ln, 32);
    mu = s * (1.0f / 1024.0f);
    const float var = fmaxf(q * (1.0f / 1024.0f) - mu * mu, 0.0f);
    rstd = __builtin_amdgcn_rsqf(var + LN_EPS);
}
__device__ __forceinline__ void row_stats4_lds(LAS unsigned char* sp, int rl, float& mu, float& rstd) {
    const f32x4 a = *(const LAS f32x4*)(sp + rl * 32), b = *(const LAS f32x4*)(sp + rl * 32 + 16);
    const float s = (a.x + a.z) + (b.x + b.z), q = (a.y + a.w) + (b.y + b.w);
    mu = s * (1.0f / 1024.0f);
    rstd = __builtin_amdgcn_rsqf(fmaxf(q * (1.0f / 1024.0f) - mu * mu, 0.0f) + LN_EPS);
}
__device__ __forceinline__ void stats_publish(LAS unsigned char* xl, float* STO, int pm, int slot, int wr, int wc, int fr, int fq) {
    asm volatile("s_waitcnt lgkmcnt(0)" ::: "memory"); __builtin_amdgcn_s_barrier(); asm volatile("" ::: "memory");
    if (fq == 0) {
#pragma unroll
        for (int ai = 0; ai < 2; ++ai) {
            const int rl = ai * HALF + wr * 64 + wc * 16 + fr;
            const f32x4 a = *(const LAS f32x4*)(xl + rl * 32), b = *(const LAS f32x4*)(xl + rl * 32 + 16);
            *(f32x2*)(STO + (size_t)(pm * BM + rl) * 8 + slot * 2) = (f32x2){(a.x + a.z) + (b.x + b.z), (a.y + a.w) + (b.y + b.w)};
        }
    }
}

#define XB_TMO      128
#define XB_XCNT(j)  (256  + 64 * (j))
#define XB_XSUB(j)  (1280 + 64 * (j))
#define XB_XGEN(j)  (2304 + 64 * (j))
#define XB_TOP      3328
#define XB_TOPGEN   3392
#define XCD_BAR_WORDS 3456
#define XB_SPIN_CAP (1u << 20)
__device__ __forceinline__ unsigned xb_ld(unsigned* p)              { return __hip_atomic_load(p, __ATOMIC_RELAXED, __HIP_MEMORY_SCOPE_AGENT); }
__device__ __forceinline__ unsigned xb_add(unsigned* p, unsigned v) { return __hip_atomic_fetch_add(p, v, __ATOMIC_RELAXED, __HIP_MEMORY_SCOPE_AGENT); }
__device__ __forceinline__ unsigned xb_xcc_id() { return (unsigned)__builtin_amdgcn_s_getreg((3 << 11) | 20) & 0xFu; }
#define XB_SPIN(cond, bar) do { unsigned _sp = 0; while (cond) { __builtin_amdgcn_s_sleep(1); \
    if ((++_sp & 255u) == 0u) { if (xb_ld(&(bar)[XB_TMO])) break; if (_sp > XB_SPIN_CAP) { atomicAdd(&(bar)[XB_TMO], 1u); break; } } } } while (0)
__device__ __forceinline__ void xcd_barrier_complete(unsigned* bar, unsigned x, unsigned& nloc, unsigned& nx) {
    const unsigned G = gridDim.x * gridDim.y * gridDim.z;
    unsigned sum, cnt, mine, sp = 0u;
    for (;;) {
        sum = 0u; cnt = 0u;
#pragma unroll 1
        for (unsigned j = 0; j < 16; ++j) { const unsigned c = xb_ld(&bar[XB_XCNT(j)]); sum += c; cnt += (c > 0u) ? 1u : 0u; }
        mine = xb_ld(&bar[XB_XCNT(x)]);
        if (sum == G) break;
        __builtin_amdgcn_s_sleep(1);
        if ((++sp & 255u) == 0u) { if (xb_ld(&bar[XB_TMO])) break; if (sp > XB_SPIN_CAP) { atomicAdd(&bar[XB_TMO], 1u); break; } }
    }
    nloc = mine > 0u ? mine : 1u; nx = cnt > 0u ? cnt : 1u;
}
__device__ __forceinline__ void xcd_barrier(unsigned* bar, unsigned x, volatile LAS unsigned* st, bool is_t0) {
    asm volatile("s_waitcnt vmcnt(0)" ::: "memory");
    __syncthreads();
    if (is_t0) {
        __builtin_amdgcn_s_waitcnt(0);
        unsigned nloc = st[0], nx = st[1];
        if (nloc == 0u) { xcd_barrier_complete(bar, x, nloc, nx); st[0] = nloc; st[1] = nx; }
        const unsigned old = xb_add(&bar[XB_XSUB(x)], 1u);
        const unsigned gen = old / nloc;
        if (old + 1u == (gen + 1u) * nloc) {
            __builtin_amdgcn_fence(__ATOMIC_RELEASE, "agent");
            asm volatile("s_waitcnt vmcnt(0)" ::: "memory");
            const unsigned og = xb_add(&bar[XB_TOP], 1u);
            const unsigned tg = og / nx;
            if (og + 1u == (tg + 1u) * nx) xb_add(&bar[XB_TOPGEN], 1u);
            else XB_SPIN(xb_ld(&bar[XB_TOPGEN]) == tg, bar);
            __builtin_amdgcn_fence(__ATOMIC_ACQUIRE, "agent");
            asm volatile("s_waitcnt vmcnt(0)" ::: "memory");
        } else {
            XB_SPIN(xb_ld(&bar[XB_TOPGEN]) == gen, bar);
            __builtin_amdgcn_fence(__ATOMIC_ACQUIRE, "agent");
            asm volatile("s_waitcnt vmcnt(0)" ::: "memory");
        }
    }
    __syncthreads();
}

__device__ __forceinline__ int lds_byte(int r, int c) { const int st = (r >> 4) * 2 + (c >> 5), rr = r & 15, cc = c & 31, ob = rr * 64 + cc * 2; return st * 1024 + (ob ^ (((ob >> 9) & 1) << 5)); }
__device__ __forceinline__ void stage_rc(int b, int& R, int& C) { const int st = b / 1024, sb = b % 1024, swz = sb ^ (((sb >> 9) & 1) << 5); R = (st >> 1) * 16 + swz / 64; C = (st & 1) * 32 + (swz % 64) / 2; }
__device__ __forceinline__ int perm32(int rho) { const int n = rho >> 4, i = rho & 15; return 8 * (i >> 2) + 4 * n + (i & 3); }

struct Unit { int pm, pn; };
__device__ __forceinline__ bool unit_next(int i, int nM, int nN, int G, int c, Unit& u) {
    const int nwg = nM * nN;
    const long L = (long)i * G + c; if (L >= nwg) return false;
    int wgid = (int)L; { const int q = nwg / NXCD, r = nwg % NXCD, xcd = wgid % NXCD, off = wgid / NXCD; wgid = (xcd < r ? xcd * (q + 1) : r * (q + 1) + (xcd - r) * q) + off; }
    const int nig = WGM * nN, gid = wgid / nig, fm = gid * WGM, gsz = (nM - fm) < WGM ? (nM - fm) : WGM;
    u.pm = fm + ((wgid % nig) % gsz); u.pn = (wgid % nig) / gsz; return true;
}
template <int GM> __device__ __forceinline__ void unit_off(const Unit& u, int lda, int ldb, size_t& ao, size_t& bo, size_t& bo1) {
    if (GM == 0) { ao = (size_t)u.pm * 256 * lda * 2; bo = (size_t)u.pn * 256 * ldb * 2; }
    if (GM == 1) { ao = (size_t)u.pm * 256 * lda * 2; const int b = u.pn >> 4, j = u.pn & 15;
        bo = ((size_t)(b * 4096 + 1 + 128 * j) * ldb + (size_t)(u.pm >> 1) * 256) * 2; bo1 = ((size_t)(b * 4096 + 3968 - 128 * j) * ldb + (size_t)(u.pm >> 1) * 256) * 2; }
    if (GM == 2) { ao = (size_t)(u.pm & 15) * 256 * lda * 2; bo = ((size_t)(u.pm >> 4) * 1024 + (size_t)u.pn * 128) * ldb * 2; bo1 = bo + 4096; }
    if (GM == 3) { ao = ((size_t)u.pm * 256 * lda + (size_t)u.pn * 256) * 2; bo = (size_t)u.pn * 256 * ldb * 2; }
    if (GM != 1 && GM != 2) bo1 = bo + (size_t)HALF * ldb * 2;
}

template <int GM, bool REV = false, class Epi>
__device__ __forceinline__ void gemm_phase(LAS unsigned char* lds, int wave_id, const bf16_t* Ab, const bf16_t* Bb, int lda, int ldb, int K, int nM, int nN, const Epi& E) {
    unsigned z_ = 0u; asm volatile("" : "+v"(z_));   int tid_ = wave_id * 64 + (int)__builtin_amdgcn_mbcnt_hi(~0u, __builtin_amdgcn_mbcnt_lo(~0u, z_));
    const int tid = tid_, wid = __builtin_amdgcn_readfirstlane(tid >> 6), lane = tid & 63, wr = wid >> 2, wc = wid & 3, fr = lane & 15, fq = lane >> 4;
    const int nt = K / BK; const int G = gridDim.x, cblk = blockIdx.x;
    constexpr bool MIR = (GM == 1);
    unsigned voffA, voffB, voffBm;
    { int R, C; stage_rc(tid * 16, R, C); const int Rb = (R & ~31) + perm32(R & 31);
        voffA = (unsigned)(R * lda + C) * 2u; voffB = (unsigned)(Rb * ldb + C) * 2u; voffBm = (unsigned)((127 - Rb) * ldb + C) * 2u; }
    const long r64A = (long)64 * lda * 2, r64B = (long)64 * ldb * 2;
    const size_t kstep = (size_t)(BK * 2);
    const size_t hstepA = (size_t)HALF * lda * 2, hstepB = (GM == 2) ? (size_t)4096 : (size_t)HALF * ldb * 2;
    constexpr bool SKIPX = (GM == 2);
    const unsigned ldsw = (unsigned)wid * 1024u;
    const int aoff = lds_byte(wr * 64 + fr, fq * 8), boff = lds_byte(wc * 32 + fr, fq * 8);
#define PG8_SA(b, h) (((b) * 2 + (h)) * HTB)
#define PG8_SB(b, h) ((4 + (b) * 2 + (h)) * HTB)
#define PG8_STAGE_(bufoff, gbase, voff, r64) do { _Pragma("unroll") for (int _i = 0; _i < 2; ++_i) { const char* g_ = (const char*)(gbase) + (long)_i * (r64); asm volatile("" : "+s"(g_));   \
        __builtin_amdgcn_global_load_lds((const unsigned*)(g_ + (voff)), (LAS unsigned*)(lds + (bufoff) + ldsw + _i * 8192), 16, 0, 0); } } while (0)
#define PG8_STAGE(bufoff, gbase, voff) PG8_STAGE_##voff(bufoff, gbase)
#define PG8_STAGE_voffA(bufoff, gbase) PG8_STAGE_(bufoff, gbase, voffA, r64A)
#define PG8_STAGE_voffB(bufoff, gbase) PG8_STAGE_(bufoff, gbase, voffB, r64B)
#define PG8_STAGEB1(bufoff, gbase) do { if (MIR) PG8_STAGE_(bufoff, gbase, voffBm, -r64B); else PG8_STAGE_(bufoff, gbase, voffB, r64B); } while (0)
#define PG8_LDA(dst, b, h) do { _Pragma("unroll") for (int m = 0; m < 4; ++m) _Pragma("unroll") for (int k = 0; k < 2; ++k) dst[m][k] = *(const LAS bf16x8*)(lds + PG8_SA(b, h) + aoff + m * 2048 + k * 1024); } while (0)
#define PG8_LDB(dst, b, h) do { _Pragma("unroll") for (int n = 0; n < 2; ++n) _Pragma("unroll") for (int k = 0; k < 2; ++k) dst[n][k] = *(const LAS bf16x8*)(lds + PG8_SB(b, h) + boff + n * 2048 + k * 1024); } while (0)
#define PG8_MMA(ai, bj, At, Bt) do { __builtin_amdgcn_s_setprio(1); _Pragma("unroll") for (int m = 0; m < 4; ++m) _Pragma("unroll") for (int n = 0; n < 2; ++n) _Pragma("unroll") for (int k = 0; k < 2; ++k) \
        acc[ai][bj][m][n] = __builtin_amdgcn_mfma_f32_16x16x32_bf16(Bt[n][k], At[m][k], acc[ai][bj][m][n], 0, 0, 0); __builtin_amdgcn_s_setprio(0); } while (0)
#define PG8_WAIT_V(n) asm volatile("s_waitcnt vmcnt(" #n ")" ::: "memory")
#define PG8_WAIT_L(n) asm volatile("s_waitcnt lgkmcnt(" #n ")" ::: "memory")
#define PG8_BAR __builtin_amdgcn_s_barrier()
#define PG8_SCHED __builtin_amdgcn_sched_barrier(0)
    Unit cur, nxt; int ui = 0;
#define PG8_RI(i) (REV ? ((nM * nN + G - 1) / G - 1 - (i)) : (i))
    (void)unit_next(PG8_RI(0), nM, nN, G, cblk, cur);
    f32x4 acc[2][2][4][2];
#pragma unroll
    for (int a = 0; a < 2; ++a)
#pragma unroll
        for (int b = 0; b < 2; ++b)
#pragma unroll
            for (int m = 0; m < 4; ++m)
#pragma unroll
                for (int n = 0; n < 2; ++n) acc[a][b][m][n] = (f32x4){0.f, 0.f, 0.f, 0.f};
    bf16x8 At[4][2], B0[2][2], B1[2][2];
    size_t ao, bo, bo1; unit_off<GM>(cur, lda, ldb, ao, bo, bo1);
    const char* cA = (const char*)Ab + ao; const char* cB = (const char*)Bb + bo; const char* cB1 = (const char*)Bb + bo1;
    PG8_STAGE(PG8_SB(0, 0), cB, voffB); PG8_STAGE(PG8_SA(0, 0), cA, voffA); PG8_STAGEB1(PG8_SB(0, 1), cB1); PG8_STAGE(PG8_SA(0, 1), cA + hstepA, voffA);
    if (wr == 1) PG8_BAR;
    PG8_WAIT_V(4); PG8_BAR;
    PG8_STAGE(PG8_SB(1, 0), cB + kstep, voffB); PG8_STAGE(PG8_SA(1, 0), cA + kstep, voffA); PG8_STAGEB1(PG8_SB(1, 1), cB1 + kstep);
    PG8_WAIT_V(6); PG8_BAR;
    for (;;) {
        const bool has_next = (!REV || ui + 1 < (nM * nN + G - 1) / G) && unit_next(PG8_RI(ui + 1), nM, nN, G, cblk, nxt);
        const char* nA = cA; const char* nB = cB; const char* nB1 = cB1;
        if (has_next) { unit_off<GM>(nxt, lda, ldb, ao, bo, bo1); nA = (const char*)Ab + ao; nB = (const char*)Bb + bo; nB1 = (const char*)Bb + bo1; }
#pragma unroll 1
        for (int t = 0; t < nt; t += 2) {
            const bool last = (t == nt - 2);
            if (Epi::SPF) { if (last) {
                const char* sp_ = (const char*)E.spf_src() + (size_t)cur.pm * 8192 + (size_t)wid * 1024; asm volatile("" : "+s"(sp_));
                const unsigned lo_ = (unsigned)__builtin_amdgcn_mbcnt_hi(~0u, __builtin_amdgcn_mbcnt_lo(~0u, 0u)) * 16u;
                __builtin_amdgcn_global_load_lds((const unsigned*)(sp_ + lo_), (LAS unsigned*)(lds + LDS_SPF + ldsw), 16, 0, 0); } }
            if (Epi::TPF) { if (last) {
                const int b_ = cur.pn >> 4, j_ = cur.pn & 15;
                const size_t t0_ = (wid < 4) ? (size_t)(b_ * 4096 + 1 + 128 * j_) : (size_t)(b_ * 4096 + 3968 - 128 * j_);
                const char* sp_ = (const char*)E.spf_src() + t0_ * 32 + (size_t)(wid & 3) * 1024; asm volatile("" : "+s"(sp_));
                const unsigned lo_ = (unsigned)__builtin_amdgcn_mbcnt_hi(~0u, __builtin_amdgcn_mbcnt_lo(~0u, 0u)) * 16u;
                __builtin_amdgcn_global_load_lds((const unsigned*)(sp_ + lo_), (LAS unsigned*)(lds + LDS_SPF + ldsw), 16, 0, 0); } }
            if (Epi::NVEC > 0) { if (last) {
                const unsigned lo4_ = (unsigned)__builtin_amdgcn_mbcnt_hi(~0u, __builtin_amdgcn_mbcnt_lo(~0u, 0u)) * 4u;
                const size_t vo_ = ((size_t)E.vec_off(cur.pm, cur.pn) + (size_t)(wid & 3) * 64) * 4;
#define PG8_VEC(k_) do { const char* vp_ = (const char*)E.vec_src(k_) + vo_; asm volatile("" : "+s"(vp_)); \
                    __builtin_amdgcn_global_load_lds((const unsigned*)(vp_ + lo4_), (LAS unsigned*)(lds + LDS_VEC + (k_) * 1024 + (wid & 3) * 256), 4, 0, 0); } while (0)
                if (wid < 4) { PG8_VEC(0); if (Epi::NVEC > 2) PG8_VEC(2); }
                else { if (Epi::NVEC > 1) PG8_VEC(1); }
#undef PG8_VEC
            } }
            const char* a1 = cA + (size_t)(t + 1) * kstep;
            const char* a2 = last ? nA : cA + (size_t)(t + 2) * kstep; const char* b2 = last ? nB : cB + (size_t)(t + 2) * kstep;
            const char* a3 = a2 + kstep; const char* b3 = b2 + kstep;
            const char* b2h = MIR ? (last ? nB1 : cB1 + (size_t)(t + 2) * kstep) : b2 + hstepB; const char* b3h = b2h + kstep;
            PG8_LDB(B0, 0, 0); PG8_SCHED; PG8_LDA(At, 0, 0); PG8_STAGE(PG8_SA(1, 1), a1 + hstepA, voffA);
            PG8_WAIT_L(8); PG8_BAR; PG8_WAIT_L(0); PG8_MMA(0, 0, At, B0); PG8_BAR; PG8_SCHED;
            PG8_LDB(B1, 0, 1); PG8_STAGE(PG8_SB(0, 0), b2, voffB);
            PG8_BAR; PG8_WAIT_L(0); if (!SKIPX) PG8_MMA(0, 1, At, B1); PG8_BAR;
            PG8_LDA(At, 0, 1); PG8_STAGE(PG8_SA(0, 0), a2, voffA);
            PG8_BAR; PG8_WAIT_L(0); if (!SKIPX) PG8_MMA(1, 0, At, B0); PG8_BAR; PG8_SCHED;
            PG8_STAGEB1(PG8_SB(0, 1), b2h);
            PG8_WAIT_V(6); PG8_BAR; PG8_MMA(1, 1, At, B1); PG8_BAR;
            PG8_LDB(B0, 1, 0); PG8_SCHED; PG8_LDA(At, 1, 0); PG8_STAGE(PG8_SA(0, 1), a2 + hstepA, voffA);
            PG8_WAIT_L(8); PG8_BAR; PG8_WAIT_L(0); PG8_MMA(0, 0, At, B0); PG8_BAR; PG8_SCHED;
            PG8_LDB(B1, 1, 1); PG8_STAGE(PG8_SB(1, 0), b3, voffB);
            PG8_BAR; PG8_WAIT_L(0); if (!SKIPX) PG8_MMA(0, 1, At, B1); PG8_BAR;
            PG8_LDA(At, 1, 1); PG8_STAGE(PG8_SA(1, 0), a3, voffA);
            PG8_BAR; PG8_WAIT_L(0); if (!SKIPX) PG8_MMA(1, 0, At, B0); PG8_BAR; PG8_SCHED;
            PG8_STAGEB1(PG8_SB(1, 1), b3h);
            PG8_WAIT_V(6); PG8_BAR; PG8_MMA(1, 1, At, B1); PG8_BAR;
        }
        if constexpr (!Epi::AFTER_DRAIN) { int pm_ = cur.pm, pn_ = cur.pn, ln_ = lane;
          asm volatile("" : "+s"(pm_), "+s"(pn_), "+v"(ln_));
          E(acc, pm_, pn_, wr, wc, ln_ & 15, ln_ >> 4, lds + LDS_STAGE); }
        if (!has_next) break;
#pragma unroll
        for (int a = 0; a < 2; ++a)
#pragma unroll
            for (int b = 0; b < 2; ++b)
#pragma unroll
                for (int m = 0; m < 4; ++m)
#pragma unroll
                    for (int n = 0; n < 2; ++n) acc[a][b][m][n] = (f32x4){0.f, 0.f, 0.f, 0.f};
        cur = nxt; cA = nA; cB = nB; cB1 = nB1; ++ui;
    }
    PG8_WAIT_V(0);
    if (wr == 0) PG8_BAR;
    PG8_BAR;
    if constexpr (Epi::AFTER_DRAIN) { int pm_ = cur.pm, pn_ = cur.pn, ln_ = lane;
        asm volatile("" : "+s"(pm_), "+s"(pn_), "+v"(ln_));
        E(acc, pm_, pn_, wid, wr, wc, ln_ & 15, ln_ >> 4, lds + LDS_STAGE); }
#undef PG8_SA
#undef PG8_SB
#undef PG8_STAGE
#undef PG8_STAGE_
#undef PG8_STAGE_voffA
#undef PG8_STAGE_voffB
#undef PG8_STAGEB1
#undef PG8_LDA
#undef PG8_LDB
#undef PG8_MMA
#undef PG8_WAIT_V
#undef PG8_WAIT_L
#undef PG8_BAR
#undef PG8_SCHED
#undef PG8_RI
}


template <int ACT, int STATS, bool FOLD> struct EpiAct {
    static constexpr bool TPF = false, AFTER_DRAIN = false, SPF = FOLD; static constexpr int NVEC = FOLD ? 2 : 0;
    __device__ __forceinline__ const float* spf_src() const { return ST; }
    __device__ __forceinline__ const float* vec_src(int k) const { return k ? cb : c1; }
    __device__ __forceinline__ int vec_off(int pm, int pn) const { return pn * 256; }
    bf16_t* O; int ldc; const float* ST; const float* c1; const float* cb; float* STO;
    __device__ __forceinline__ void operator()(const f32x4 (&acc)[2][2][4][2], int pm, int pn, int wr, int wc, int fr, int fq, LAS unsigned char* xl) const {
        const int urow0 = pm * BM + wr * 64, ucol0 = pn * BM + wc * 32;
        const unsigned lst = (unsigned)(fr * ldc + fq * 8) * 2u;
        constexpr bool fold = FOLD;
        f32x4 vc1[2][2], vcb[2][2];
#pragma unroll
        for (int bj = 0; bj < 2; ++bj)
#pragma unroll
            for (int n = 0; n < 2; ++n) {
                const int vo = (wc * 32 + bj * HALF + n * 4 + fq * 8) * 4;
                vc1[bj][n] = fold ? *(const LAS f32x4*)(xl + (LDS_VEC - LDS_STAGE) + vo) : (f32x4){0.f, 0.f, 0.f, 0.f};
                vcb[bj][n] = fold ? *(const LAS f32x4*)(xl + (LDS_VEC - LDS_STAGE) + 1024 + vo) : (f32x4){0.f, 0.f, 0.f, 0.f}; }
        const bool dostats = (STATS == 1) || (STATS == 2 && pn >= 4);
        const int slot = (STATS == 2 ? (pn - 4) : pn);
#pragma unroll
        for (int ai = 0; ai < 2; ++ai)
#pragma unroll
            for (int m = 0; m < 4; ++m) {
                const int urow = urow0 + ai * HALF + m * 16;
                float mu = 0.f, rstd = 1.f;
                if (fold) row_stats4_lds(xl + (LDS_SPF - LDS_STAGE), ai * HALF + wr * 64 + m * 16 + fr, mu, rstd);
                float s = 0.f, q = 0.f;
#pragma unroll
                for (int bj = 0; bj < 2; ++bj) {
                    f32x4 v0 = acc[ai][bj][m][0], v1 = acc[ai][bj][m][1];
                    v0 = (v0 - mu * vc1[bj][0]) * rstd + vcb[bj][0];
                    v1 = (v1 - mu * vc1[bj][1]) * rstd + vcb[bj][1];
                    if (ACT == 1) {
#pragma unroll
                        for (int j = 0; j < 4; ++j) { v0[j] = gelu_tanh(v0[j]); v1[j] = gelu_tanh(v1[j]); } }
                    if (ACT == 2) {
#pragma unroll
                        for (int j = 0; j < 4; ++j) { v0[j] = fmaxf(v0[j], 0.f); v1[j] = fmaxf(v1[j], 0.f); }
                        v0 = v0 * v0; v1 = v1 * v1; }
                    if (STATS != 0) {
                        s += ((v0[0] + v0[1]) + (v0[2] + v0[3])) + ((v1[0] + v1[1]) + (v1[2] + v1[3]));
                        q += ((v0[0] * v0[0] + v0[1] * v0[1]) + (v0[2] * v0[2] + v0[3] * v0[3])) + ((v1[0] * v1[0] + v1[1] * v1[1]) + (v1[2] * v1[2] + v1[3] * v1[3])); }
                    u32x4 w; w.x = pk2(v0[0], v0[1]); w.y = pk2(v0[2], v0[3]); w.z = pk2(v1[0], v1[1]); w.w = pk2(v1[2], v1[3]);
                    *UP(u32x4, O, ((size_t)urow * ldc + ucol0 + bj * HALF) * 2, lst) = w;
                }
                if (STATS != 0) {
                    if (dostats) {
                        const int ln = fq * 16 + fr; s += shx(s, ln, 16); s += shx(s, ln, 32); q += shx(q, ln, 16); q += shx(q, ln, 32);
                        if (fq == 0) *(LAS f32x2*)(xl + (ai * HALF + wr * 64 + m * 16 + fr) * 32 + wc * 8) = (f32x2){s, q};
                    } }
                asm volatile("" ::: "memory");
            }
        if (STATS != 0) { if (dostats) stats_publish(xl, STO, pm, slot, wr, wc, fr, fq); }
    }
};

template <bool RAW, bool BIAS, bool F32> struct EpiRes {
    static constexpr bool TPF = false, AFTER_DRAIN = false, SPF = !RAW; static constexpr int NVEC = RAW ? 0 : (BIAS ? 3 : 2);
    __device__ __forceinline__ const float* spf_src() const { return STp; }
    __device__ __forceinline__ const float* vec_src(int k) const { return k == 0 ? g : (k == 1 ? b : bias); }
    __device__ __forceinline__ int vec_off(int pm, int pn) const { return pn * 256; }
    const float* xraw; const bf16_t* tprev; const float* STp; const float* g; const float* b; const float* bias;
    bf16_t* O; float* Of; float* STO;
    __device__ __forceinline__ void operator()(const f32x4 (&acc)[2][2][4][2], int pm, int pn, int wr, int wc, int fr, int fq, LAS unsigned char* xl) const {
        const int urow0 = pm * BM + wr * 64, ucol0 = pn * BM + wc * 32;
        const unsigned l16 = (unsigned)(fr * DM + fq * 8) * 2u, l32 = (unsigned)(fr * DM + fq * 8) * 4u;
        constexpr bool raw = RAW;
        f32x4 vg[2][2], vb[2][2];
#pragma unroll
        for (int bj = 0; bj < 2; ++bj)
#pragma unroll
            for (int n = 0; n < 2; ++n) {
                const int vo = (wc * 32 + bj * HALF + n * 4 + fq * 8) * 4;
                vg[bj][n] = raw ? (f32x4){1.f, 1.f, 1.f, 1.f} : *(const LAS f32x4*)(xl + (LDS_VEC - LDS_STAGE) + vo);
                vb[bj][n] = raw ? (f32x4){0.f, 0.f, 0.f, 0.f} : ALPHA * *(const LAS f32x4*)(xl + (LDS_VEC - LDS_STAGE) + 1024 + vo);
                if (BIAS) vb[bj][n] += *(const LAS f32x4*)(xl + (LDS_VEC - LDS_STAGE) + 2048 + vo); }
        constexpr int LA = RAW ? 1 : 2;
        u32x4 tq[8][2]; f32x4 xq[8][2][2];
#define RES_ISSUE(r_) do { const int ai_ = (r_) >> 2, m_ = (r_) & 3; _Pragma("unroll") for (int bj = 0; bj < 2; ++bj) { \
            const size_t uo_ = (size_t)(urow0 + ai_ * HALF + m_ * 16) * DM + ucol0 + bj * HALF; \
            if (raw) { xq[r_][bj][0] = *UP(const f32x4, xraw, uo_ * 4, l32); xq[r_][bj][1] = *UP(const f32x4, xraw, uo_ * 4 + 16, l32); } \
            else tq[r_][bj] = *UP(const u32x4, tprev, uo_ * 2, l16); } } while (0)
#pragma unroll
        for (int r = 0; r < LA; ++r) RES_ISSUE(r);
#pragma unroll
        for (int r = 0; r < 8; ++r) {
                const int ai = r >> 2, m = r & 3;
                if (r + LA < 8) RES_ISSUE(r + LA);
                float mu = 0.f, rstd = 1.f;
                if (!raw) row_stats4_lds(xl + (LDS_SPF - LDS_STAGE), ai * HALF + wr * 64 + m * 16 + fr, mu, rstd);
                float s = 0.f, q = 0.f;
#pragma unroll
                for (int bj = 0; bj < 2; ++bj) {
                    const size_t uoff = (size_t)(urow0 + ai * HALF + m * 16) * DM + ucol0 + bj * HALF;
                    f32x4 r0, r1;
                    if (raw) { r0 = xq[r][bj][0]; r1 = xq[r][bj][1]; }
                    else { const u32x4 w = tq[r][bj];
                        r0 = (f32x4){bf_lo(w.x), bf_hi(w.x), bf_lo(w.y), bf_hi(w.y)}; r1 = (f32x4){bf_lo(w.z), bf_hi(w.z), bf_lo(w.w), bf_hi(w.w)}; }
                    const float ars = ALPHA * rstd;
                    const f32x4 v0 = (r0 - mu) * ars * vg[bj][0] + (acc[ai][bj][m][0] + vb[bj][0]);
                    const f32x4 v1 = (r1 - mu) * ars * vg[bj][1] + (acc[ai][bj][m][1] + vb[bj][1]);
                    s += ((v0[0] + v0[1]) + (v0[2] + v0[3])) + ((v1[0] + v1[1]) + (v1[2] + v1[3]));
                    q += ((v0[0] * v0[0] + v0[1] * v0[1]) + (v0[2] * v0[2] + v0[3] * v0[3])) + ((v1[0] * v1[0] + v1[1] * v1[1]) + (v1[2] * v1[2] + v1[3] * v1[3]));
                    if (F32) { *UP(f32x4, Of, uoff * 4, l32) = v0; *UP(f32x4, Of, uoff * 4 + 16, l32) = v1; }
                    else { u32x4 w; w.x = pk2(v0[0], v0[1]); w.y = pk2(v0[2], v0[3]); w.z = pk2(v1[0], v1[1]); w.w = pk2(v1[2], v1[3]); *UP(u32x4, O, uoff * 2, l16) = w; }
                }
                const int ln = fq * 16 + fr; s += shx(s, ln, 16); s += shx(s, ln, 32); q += shx(q, ln, 16); q += shx(q, ln, 32);
                if (fq == 0) *(LAS f32x2*)(xl + (ai * HALF + wr * 64 + m * 16 + fr) * 32 + wc * 8) = (f32x2){s, q};
                asm volatile("" ::: "memory");
            }
#undef RES_ISSUE
        stats_publish(xl, STO, pm, pn, wr, wc, fr, fq);
    }
};

struct EpiFinal {
    static constexpr bool TPF = false, AFTER_DRAIN = true, SPF = true; static constexpr int NVEC = 3;
    __device__ __forceinline__ const float* spf_src() const { return STp; }
    __device__ __forceinline__ const float* vec_src(int k) const { return k == 0 ? g : (k == 1 ? b : bias); }
    __device__ __forceinline__ int vec_off(int pm, int pn) const { return pn * 256; }
    const bf16_t* tprev; const float* STp; const float* g; const float* b; const float* bias; const float* g2; const float* b2;
    float* Of; unsigned long long* xbuf; unsigned* cnt;
    __device__ __forceinline__ void operator()(f32x4 (&acc)[2][2][4][2], int pm, int pn, int wid, int wr, int wc, int fr, int fq, LAS unsigned char* xl) const {
        const int urow0 = pm * BM + wr * 64, ucol0 = pn * BM + wc * 32;
        const unsigned l16 = (unsigned)(fr * DM + fq * 8) * 2u, l32 = (unsigned)(fr * DM + fq * 8) * 4u;
        const int ln = fq * 16 + fr;
        LAS f32x2* S = (LAS f32x2*)(xl + 8256);
        {
            f32x4 vg[2][2], vb[2][2];
#pragma unroll
            for (int bj = 0; bj < 2; ++bj)
#pragma unroll
                for (int n = 0; n < 2; ++n) { const int vo = (wc * 32 + bj * HALF + n * 4 + fq * 8) * 4;
                    vg[bj][n] = *(const LAS f32x4*)(xl + (LDS_VEC - LDS_STAGE) + vo);
                    vb[bj][n] = ALPHA * *(const LAS f32x4*)(xl + (LDS_VEC - LDS_STAGE) + 1024 + vo) + *(const LAS f32x4*)(xl + (LDS_VEC - LDS_STAGE) + 2048 + vo); }
#pragma unroll
            for (int ai = 0; ai < 2; ++ai)
#pragma unroll
                for (int m = 0; m < 4; ++m) {
                    float mu, rstd_; row_stats4_lds(xl + (LDS_SPF - LDS_STAGE), ai * HALF + wr * 64 + m * 16 + fr, mu, rstd_);
                    const float ars = ALPHA * rstd_;
                    float s = 0.f, q = 0.f;
#pragma unroll
                    for (int bj = 0; bj < 2; ++bj) {
                        const size_t uoff = (size_t)(urow0 + ai * HALF + m * 16) * DM + ucol0 + bj * HALF;
                        const u32x4 w = *UP(const u32x4, tprev, uoff * 2, l16);
                        const f32x4 r0 = (f32x4){bf_lo(w.x), bf_hi(w.x), bf_lo(w.y), bf_hi(w.y)}, r1 = (f32x4){bf_lo(w.z), bf_hi(w.z), bf_lo(w.w), bf_hi(w.w)};
                        const f32x4 v0 = (r0 - mu) * ars * vg[bj][0] + (acc[ai][bj][m][0] + vb[bj][0]);
                        const f32x4 v1 = (r1 - mu) * ars * vg[bj][1] + (acc[ai][bj][m][1] + vb[bj][1]);
                        s += ((v0[0] + v0[1]) + (v0[2] + v0[3])) + ((v1[0] + v1[1]) + (v1[2] + v1[3]));
                        q += ((v0[0] * v0[0] + v0[1] * v0[1]) + (v0[2] * v0[2] + v0[3] * v0[3])) + ((v1[0] * v1[0] + v1[1] * v1[1]) + (v1[2] * v1[2] + v1[3] * v1[3]));
                        acc[ai][bj][m][0] = v0; acc[ai][bj][m][1] = v1;
                    }
                    s += shx(s, ln, 16); s += shx(s, ln, 32); q += shx(q, ln, 16); q += shx(q, ln, 32);
                    if (fq == 0) *(LAS f32x2*)(xl + (ai * HALF + wr * 64 + m * 16 + fr) * 32 + wc * 8) = (f32x2){s, q};
                    if (m & 1) asm volatile("" ::: "memory");
                }
        }
        asm volatile("s_waitcnt lgkmcnt(0)" ::: "memory"); __builtin_amdgcn_s_barrier(); asm volatile("" ::: "memory");
        const int rl = wid * 32 + (ln & 31);
        if (ln < 32) {
            const f32x4 a = *(const LAS f32x4*)(xl + rl * 32), c = *(const LAS f32x4*)(xl + rl * 32 + 16);
            const float s = (a.x + a.z) + (c.x + c.z), q = (a.y + a.w) + (c.y + c.w);
            __hip_atomic_store(xbuf + ((size_t)(pm * BM + rl) * 4 + pn), ((unsigned long long)__float_as_uint(q) << 32) | __float_as_uint(s), __ATOMIC_RELAXED, __HIP_MEMORY_SCOPE_AGENT);
        }
        asm volatile("s_waitcnt vmcnt(0)" ::: "memory");
        if (ln == 0) __hip_atomic_fetch_add(cnt + 64 * pm, 1u, __ATOMIC_RELAXED, __HIP_MEMORY_SCOPE_AGENT);
        if (wid == 0) {
            unsigned sp = 0;
            while ((unsigned)__builtin_amdgcn_readfirstlane(__hip_atomic_load(cnt + 64 * pm, __ATOMIC_RELAXED, __HIP_MEMORY_SCOPE_AGENT)) < 32u) { __builtin_amdgcn_s_sleep(1); if (++sp > (1u << 22)) break; }
            __builtin_amdgcn_fence(__ATOMIC_ACQUIRE, "agent");
            asm volatile("s_waitcnt vmcnt(0)" ::: "memory");
        }
        asm volatile("s_waitcnt vmcnt(0) lgkmcnt(0)" ::: "memory"); __builtin_amdgcn_s_barrier(); asm volatile("" ::: "memory");
        if (ln < 32) {
            const unsigned long long* slot = xbuf + (size_t)(pm * BM + rl) * 4; float s = 0.f, q = 0.f;
#pragma unroll
            for (int t = 0; t < 4; ++t) { const unsigned long long w = __hip_atomic_load(slot + t, __ATOMIC_RELAXED, __HIP_MEMORY_SCOPE_AGENT); s += __uint_as_float((unsigned)w); q += __uint_as_float((unsigned)(w >> 32)); }
            const float mu = s * (1.0f / 1024.0f); const float var = fmaxf(q * (1.0f / 1024.0f) - mu * mu, 0.f);
            S[rl] = (f32x2){mu, __builtin_amdgcn_rsqf(var + LN_EPS)};
        }
        asm volatile("s_waitcnt lgkmcnt(0)" ::: "memory"); __builtin_amdgcn_s_barrier(); asm volatile("" ::: "memory");
        f32x4 wg2[2][2], wb2[2][2];
#pragma unroll
        for (int bj = 0; bj < 2; ++bj)
#pragma unroll
            for (int n = 0; n < 2; ++n) { const int uc = (ucol0 + bj * HALF + n * 4) * 4; wg2[bj][n] = *UP(const f32x4, g2, uc, fq * 32); wb2[bj][n] = *UP(const f32x4, b2, uc, fq * 32); }
#pragma unroll
        for (int ai = 0; ai < 2; ++ai)
#pragma unroll
            for (int m = 0; m < 4; ++m) {
                const f32x2 sr = S[ai * HALF + wr * 64 + m * 16 + fr];
#pragma unroll
                for (int bj = 0; bj < 2; ++bj) {
                    const size_t uoff = (size_t)(urow0 + ai * HALF + m * 16) * DM + ucol0 + bj * HALF;
                    *UP(f32x4, Of, uoff * 4, l32) = (acc[ai][bj][m][0] - sr.x) * sr.y * wg2[bj][0] + wb2[bj][0];
                    *UP(f32x4, Of, uoff * 4 + 16, l32) = (acc[ai][bj][m][1] - sr.x) * sr.y * wg2[bj][1] + wb2[bj][1];
                }
            }
    }
};

struct EpiChanDft {
    static constexpr bool AFTER_DRAIN = false, SPF = false, TPF = true; static constexpr int NVEC = 2;
    __device__ __forceinline__ const float* spf_src() const { return STV; }
    __device__ __forceinline__ const float* vec_src(int k) const { return k ? c2 : c1; }
    __device__ __forceinline__ int vec_off(int pm, int pn) const { return pm * 256; }
    const float* STV; const float* c1; const float* c2; bf16_t* PT;
    __device__ __forceinline__ void operator()(f32x4 (&acc)[2][2][4][2], int pm, int pn, int wr, int wc, int fr, int fq, LAS unsigned char* xl) const {
        const int g = pm >> 1, part = pm & 1;
        const int bidx = pn >> 4, j = pn & 15;
        const int r0 = wc * 32 + fq * 8;
        const float sgn = part ? -1.0f : 1.0f;
        float kk[8];
#pragma unroll
        for (int bj = 0; bj < 2; ++bj) {
            float rs[8];
#pragma unroll
            for (int e = 0; e < 8; ++e) {
                const f32x2 a = *(const LAS f32x2*)(xl + (LDS_SPF - LDS_STAGE) + (bj ? (4096 + (127 - r0 - e) * 32) : ((r0 + e) * 32)) + g * 8);
                const float m_ = a.x * (1.0f / 256.0f); const float var = fmaxf(a.y * (1.0f / 256.0f) - m_ * m_, 0.f);
                rs[e] = __builtin_amdgcn_rsqf(var + LN_EPS);
                kk[e] = bj ? kk[e] + sgn * m_ * rs[e] : m_ * rs[e]; }
#pragma unroll
            for (int ai = 0; ai < 2; ++ai)
#pragma unroll
                for (int m = 0; m < 4; ++m)
#pragma unroll
                    for (int e = 0; e < 4; ++e) { acc[ai][bj][m][0][e] *= rs[e]; acc[ai][bj][m][1][e] *= rs[4 + e]; }
            asm volatile("" ::: "memory");
        }
#pragma unroll
        for (int ai = 0; ai < 2; ++ai)
#pragma unroll
            for (int m = 0; m < 4; ++m) {
                const int l = ai * HALF + wr * 64 + m * 16 + fr;
                const float cc1 = *(const LAS float*)(xl + (LDS_VEC - LDS_STAGE) + l * 4), cc2 = (1.0f + sgn) * *(const LAS float*)(xl + (LDS_VEC - LDS_STAGE) + 1024 + l * 4);
                bf16_t* rowp = PT + ((size_t)(bidx * 1024 + g * 256 + l) * 4096 + part * 2048 + 128 * j + r0);
                f32x4 v0 = acc[ai][0][m][0] + sgn * acc[ai][1][m][0] + cc2, v1 = acc[ai][0][m][1] + sgn * acc[ai][1][m][1] + cc2;
#pragma unroll
                for (int e = 0; e < 4; ++e) { v0[e] -= cc1 * kk[e]; v1[e] -= cc1 * kk[4 + e]; }
                u32x4 w; w.x = pk2(v0[0], v0[1]); w.y = pk2(v0[2], v0[3]); w.z = pk2(v1[0], v1[1]); w.w = pk2(v1[2], v1[3]);
                *(u32x4*)rowp = w;
                asm volatile("" ::: "memory");
            }
    }
};

struct EpiDftSym {
    static constexpr bool TPF = false, AFTER_DRAIN = false, SPF = false; static constexpr int NVEC = 0;
    __device__ __forceinline__ const float* spf_src() const { return nullptr; }
    __device__ __forceinline__ const float* vec_src(int) const { return nullptr; }
    __device__ __forceinline__ int vec_off(int, int) const { return 0; }
    bf16_t* O; const float* side;
    __device__ __forceinline__ void operator()(const f32x4 (&acc)[2][2][4][2], int pm, int pn, int wr, int wc, int fr, int fq, LAS unsigned char* xl) const {
        const int b = pm >> 4, kt = pm & 15;
        const int ucol0 = pn * HALF + wc * 32;
        f32x4 vsd[2];
#pragma unroll
        for (int n = 0; n < 2; ++n) vsd[n] = *UP(const f32x4, side, (b * 1024 + ucol0 + n * 4) * 4, fq * 32) * (1.0f / 1024.0f);
#pragma unroll
        for (int m = 0; m < 4; ++m) {
            const int k = 1 + 128 * kt + wr * 64 + m * 16 + fr;
            const f32x4 c0 = acc[0][0][m][0] + vsd[0], c1 = acc[0][0][m][1] + vsd[1], s0 = acc[1][1][m][0], s1 = acc[1][1][m][1];
            const f32x4 p0 = c0 + s0, p1 = c1 + s1, q0 = c0 - s0, q1 = c1 - s1;
            u32x4 w; w.x = pk2(p0[0], p0[1]); w.y = pk2(p0[2], p0[3]); w.z = pk2(p1[0], p1[1]); w.w = pk2(p1[2], p1[3]);
            *(u32x4*)(O + ((size_t)b * 4096 + k) * DM + ucol0 + fq * 8) = w;
            u32x4 z; z.x = pk2(q0[0], q0[1]); z.y = pk2(q0[2], q0[3]); z.z = pk2(q1[0], q1[1]); z.w = pk2(q1[2], q1[3]);
            *(u32x4*)(O + ((size_t)b * 4096 + (4096 - k)) * DM + ucol0 + fq * 8) = z;
            asm volatile("" ::: "memory");
        }
    }
};

struct EpiPlain {
    static constexpr bool TPF = false, AFTER_DRAIN = false, SPF = false; static constexpr int NVEC = 0;
    __device__ __forceinline__ const float* spf_src() const { return nullptr; }
    __device__ __forceinline__ const float* vec_src(int) const { return nullptr; }
    __device__ __forceinline__ int vec_off(int, int) const { return 0; }
    bf16_t* O; const float* scale; const float* side;
    __device__ __forceinline__ void operator()(const f32x4 (&acc)[2][2][4][2], int pm, int pn, int wr, int wc, int fr, int fq, LAS unsigned char* xl) const {
        const int urow0 = pm * BM + wr * 64, ucol0 = pn * BM + wc * 32;
        const unsigned l16 = (unsigned)(fr * DM + fq * 8) * 2u;
        f32x4 vs[2][2], vsd[2][2];
#pragma unroll
        for (int bj = 0; bj < 2; ++bj)
#pragma unroll
            for (int n = 0; n < 2; ++n) { vs[bj][n] = scale ? *UP(const f32x4, scale, (ucol0 + bj * HALF + n * 4) * 4, fq * 32) : (f32x4){1.f, 1.f, 1.f, 1.f};
                vsd[bj][n] = side ? *UP(const f32x4, side, ((pm >> 4) * 1024 + ucol0 + bj * HALF + n * 4) * 4, fq * 32) * (1.0f / 1024.0f) : (f32x4){0.f, 0.f, 0.f, 0.f}; }
#pragma unroll
        for (int ai = 0; ai < 2; ++ai)
#pragma unroll
            for (int m = 0; m < 4; ++m) {
#pragma unroll
                for (int bj = 0; bj < 2; ++bj) {
                    const f32x4 v0 = acc[ai][bj][m][0] * vs[bj][0] + vsd[bj][0], v1 = acc[ai][bj][m][1] * vs[bj][1] + vsd[bj][1];
                    u32x4 w; w.x = pk2(v0[0], v0[1]); w.y = pk2(v0[2], v0[3]); w.z = pk2(v1[0], v1[1]); w.w = pk2(v1[2], v1[3]);
                    *UP(u32x4, O, ((size_t)(urow0 + ai * HALF + m * 16) * DM + ucol0 + bj * HALF) * 2, l16) = w;
                }
                asm volatile("" ::: "memory");
            }
    }
};

__device__ __forceinline__ void tr_item(const float* W, int K, int N, bf16_t* WT, const float* gk, LAS float* scr, int item, int lane) {
    const int nblk = N / 32, kb = item / nblk, nb = item % nblk, k0 = 64 * kb, n0 = 32 * nb;
#pragma unroll 8
    for (int i = 0; i < 32; ++i) { const int kk = 2 * i + (lane >> 5); float w = W[(size_t)(k0 + kk) * N + n0 + (lane & 31)]; if (gk) w *= gk[k0 + kk]; scr[kk * 33 + (lane & 31)] = w; }
    asm volatile("s_waitcnt lgkmcnt(0)" ::: "memory");
    const int c = lane & 7;
#pragma unroll
    for (int j = 0; j < 4; ++j) { const int n = (lane >> 3) + 8 * j; const LAS float* s = scr + (8 * c) * 33 + n;
        u32x4 o; o.x = pk2(s[0 * 33], s[1 * 33]); o.y = pk2(s[2 * 33], s[3 * 33]); o.z = pk2(s[4 * 33], s[5 * 33]); o.w = pk2(s[6 * 33], s[7 * 33]);
        *(u32x4*)(WT + (size_t)(n0 + n) * K + k0 + 8 * c) = o; }
    asm volatile("s_waitcnt lgkmcnt(0)" ::: "memory");
}
__device__ __forceinline__ void colsum_item(const float* W, int K, int N, const float* g, const float* b, const float* bias, float* c1, float* cb, int item, int lane) {
    const int n = item * 64 + lane; float s1 = 0.f, s2 = 0.f;
#pragma unroll 32
    for (int k = 0; k < K; ++k) { const float w = W[(size_t)k * N + n]; s1 += bf_round(g[k] * w); s2 += b[k] * w; }
    c1[n] = s1; cb[n] = s2 + (bias ? bias[n] : 0.f);
}

__global__ void __launch_bounds__(NTHREADS) fwd_megakernel(Params p) {
    extern __shared__ __attribute__((aligned(16))) unsigned char lds_raw[];
    LAS unsigned char* lds = (LAS unsigned char*)lds_raw;
    cg::grid_group grid = cg::this_grid();
    const int G = gridDim.x, blk = blockIdx.x;
    const int NGW = G * 8; const size_t NGT = (size_t)G * NTHREADS;
    const int wave_id = __builtin_amdgcn_readfirstlane(threadIdx.x >> 6);
#define FRESH_IDS() unsigned z_ = 0u; asm volatile("" : "+v"(z_));   int tid_ = wave_id * 64 + (int)__builtin_amdgcn_mbcnt_hi(~0u, __builtin_amdgcn_mbcnt_lo(~0u, z_)); const int tid = tid_, lane = tid & 63, wave = __builtin_amdgcn_readfirstlane(tid >> 6); \
    const int gw = blk * 8 + wave; const size_t gt = (size_t)blk * NTHREADS + tid; (void)gw; (void)gt; (void)lane;
#define GAS __attribute__((address_space(1)))
#define WSP ([&]() { unsigned long long w_ = (unsigned long long)p.ws; asm volatile("" : "+s"(w_)); return (unsigned char*)(GAS unsigned char*)w_; }())
    const unsigned xcc = xb_xcc_id();
    { FRESH_IDS();
      if (tid < 4) ((volatile LAS unsigned*)(lds + LDS_STAGE + 8192))[tid] = 0u;
      __syncthreads();
      if (tid == 0) (void)xb_add(&((unsigned*)(WSP + WS_BAR))[XB_XCNT(xcc)], 1u); }
#define GSYNC_CG() do { if (p.coop) grid.sync(); } while (0)
#define GSYNC() do { if (p.coop) { FRESH_IDS(); xcd_barrier((unsigned*)(WSP + WS_BAR), xcc, (volatile LAS unsigned*)(lds + LDS_STAGE + 8192), tid == 0); } } while (0)
#define XIN (p.in[0])
#define ln1_g (p.in[1])
#define ln1_b (p.in[2])
#define ffn_w1 (p.in[3])
#define ffn_b1 (p.in[4])
#define ffn_w2 (p.in[5])
#define ffn_b2 (p.in[6])
#define ln2_g (p.in[7])
#define ln2_b (p.in[8])
#define a_w_in (p.in[9])
#define a_ln_g (p.in[10])
#define a_ln_b (p.in[11])
#define a_w_s (p.in[12])
#define a_b_s (p.in[13])
#define a_w_out (p.in[14])
#define b_w_in (p.in[15])
#define b_ln_g (p.in[16])
#define b_ln_b (p.in[17])
#define b_w_out (p.in[18])
#define c_w_in (p.in[19])
#define c_w_grp (p.in[20])
#define c_scale (p.in[21])
#define c_w_out (p.in[22])
#define H ((bf16_t*)(WSP + WS_H))
#define T1 ((bf16_t*)(WSP + WS_T1))
#define T2 ((bf16_t*)(WSP + WS_T2))
#define XB ((bf16_t*)(WSP + WS_T2))
#define W1T ((bf16_t*)(WSP + W_W1T))
#define W2T ((bf16_t*)(WSP + W_W2T))
#define AWIN ((bf16_t*)(WSP + W_AWIN))
#define AWOUT ((bf16_t*)(WSP + W_AWOUT))
#define AWS ((bf16_t*)(WSP + W_AWS))
#define BWIN ((bf16_t*)(WSP + W_BWIN))
#define BWOUT ((bf16_t*)(WSP + W_BWOUT))
#define CWIN ((bf16_t*)(WSP + W_CWIN))
#define CWOUT ((bf16_t*)(WSP + W_CWOUT))
#define CWG ((bf16_t*)(WSP + W_CWG))
#define WCD ((bf16_t*)(WSP + W_WCD))
#define DSEQ ((bf16_t*)(WSP + W_DSEQ))
#define C1FFN ((float*)(WSP + V_C1FFN))
#define CBFFN ((float*)(WSP + V_CBFFN))
#define C1MIX ((float*)(WSP + V_C1MIX))
#define CBMIX ((float*)(WSP + V_CBMIX))
#define C1CD ((float*)(WSP + V_C1CD))
#define C2CD ((float*)(WSP + V_C2CD))
#define WSROW ((float*)(WSP + V_WSROW))
#define SIDE0 ((float*)(WSP + V_SIDE0))
#define ST1 ((float*)(WSP + WS_ST1))
#define ST2 ((float*)(WSP + WS_ST2))
#define STV ((float*)(WSP + WS_STV))

#ifndef P0_REP
#define P0_REP 1
#endif
#pragma unroll 1
    for (int rep0 = 0; rep0 < P0_REP; ++rep0) {
        FRESH_IDS();
        for (size_t i = gt; i < (size_t)MT * DM / 8; i += NGT) {
            const f32x4 a = *(const f32x4*)(XIN + i * 8), b = *(const f32x4*)(XIN + i * 8 + 4);
            u32x4 w; w.x = pk2(a[0], a[1]); w.y = pk2(a[2], a[3]); w.z = pk2(b[0], b[1]); w.w = pk2(b[2], b[3]);
            *(u32x4*)(XB + i * 8) = w; }
        {
            LAS float* scr = (LAS float*)(lds + wave * 8448);
            constexpr int I_W1 = (DM / 64) * (FF / 32), I_W2 = (FF / 64) * (DM / 32), I_AIN = (DM / 64) * (2048 / 32), I_SQ = (DM / 64) * (DM / 32), I_G = (256 / 64) * (256 / 32);
            constexpr int NITEMS = 4 * I_W1 + 4 * I_W2 + 2 * I_AIN + 2 * I_SQ + 4 * I_SQ + 4 * I_G;
            for (int it = gw; it < NITEMS; it += NGW) {
                int r = it;
                if (r < 4 * I_W1) { const int l = r / I_W1; tr_item(ffn_w1 + (size_t)l * DM * FF, DM, FF, W1T + (size_t)l * DM * FF, ln1_g + l * DM, scr, r % I_W1, lane); continue; } r -= 4 * I_W1;
                if (r < 4 * I_W2) { const int l = r / I_W2; tr_item(ffn_w2 + (size_t)l * DM * FF, FF, DM, W2T + (size_t)l * DM * FF, nullptr, scr, r % I_W2, lane); continue; } r -= 4 * I_W2;
                if (r < 2 * I_AIN) { const int l = r / I_AIN; tr_item(a_w_in + (size_t)l * DM * 2048, DM, 2048, AWIN + (size_t)l * DM * 2048, l ? ln2_g + 2 * DM : nullptr, scr, r % I_AIN, lane); continue; } r -= 2 * I_AIN;
                if (r < 2 * I_SQ) { const int l = r / I_SQ; tr_item(a_w_out + (size_t)l * DM * DM, DM, DM, AWOUT + (size_t)l * DM * DM, nullptr, scr, r % I_SQ, lane); continue; } r -= 2 * I_SQ;
                if (r < I_SQ) { tr_item(b_w_in, DM, DM, BWIN, ln2_g + 0 * DM, scr, r, lane); continue; } r -= I_SQ;
                if (r < I_SQ) { tr_item(b_w_out, DM, DM, BWOUT, nullptr, scr, r, lane); continue; } r -= I_SQ;
                if (r < I_SQ) { tr_item(c_w_in, DM, DM, CWIN, ln2_g + 1 * DM, scr, r, lane); continue; } r -= I_SQ;
                if (r < I_SQ) { tr_item(c_w_out, DM, DM, CWOUT, nullptr, scr, r, lane); continue; } r -= I_SQ;
                { const int l = r / I_G; tr_item(c_w_grp + (size_t)l * 65536, 256, 256, CWG + (size_t)l * 65536, nullptr, scr, r % I_G, lane); }
            }
        }
        {
            constexpr int J_FFN = FF / 64, J_A = 2048 / 64, J_S = DM / 64;
            constexpr int NJ = 4 * J_FFN + J_A + 2 * J_S;
            for (int it = wave * G + blk; it < NJ; it += NGW) {
                int r = it;
                if (r < 4 * J_FFN) { const int l = r / J_FFN; colsum_item(ffn_w1 + (size_t)l * DM * FF, DM, FF, ln1_g + l * DM, ln1_b + l * DM, ffn_b1 + l * FF, C1FFN + l * FF, CBFFN + l * FF, r % J_FFN, lane); continue; } r -= 4 * J_FFN;
                if (r < J_A) { colsum_item(a_w_in + (size_t)DM * 2048, DM, 2048, ln2_g + 2 * DM, ln2_b + 2 * DM, nullptr, C1MIX + 3 * 2048, CBMIX + 3 * 2048, r, lane); continue; } r -= J_A;
                if (r < J_S) { colsum_item(b_w_in, DM, DM, ln2_g + 0 * DM, ln2_b + 0 * DM, nullptr, C1MIX + 1 * 2048, CBMIX + 1 * 2048, r, lane); continue; } r -= J_S;
                colsum_item(c_w_in, DM, DM, ln2_g + 1 * DM, ln2_b + 1 * DM, nullptr, C1MIX + 2 * 2048, CBMIX + 2 * 2048, r, lane);
            }
        }
        for (size_t i = gt; i < 262144; i += NGT) AWS[i] = (bf16_t)(pk2(a_w_s[i], 0.f) & 0xffffu);
        for (int r = gw; r < 2048; r += NGW) { const float s = wave_sum(a_w_s[(size_t)r * 128 + lane] + a_w_s[(size_t)r * 128 + 64 + lane], lane); if (lane == 0) WSROW[r] = s; }
        for (int r = gw; r < 2048; r += NGW) {
            const int g = r >> 9, part = (r >> 8) & 1, l = r & 255;
            float s1 = 0.f, s2 = 0.f; float v[4];
#pragma unroll
            for (int e = 0; e < 4; ++e) { const int c = lane * 4 + e; const int idx = (l * c) & 255; const float ang = (float)idx * (1.0f / 128.0f);
                const float tr = part ? sinpif(ang) : cospif(ang); const float gv = b_ln_g[g * 256 + c] * tr; v[e] = gv; s1 += bf_round(gv); s2 += b_ln_b[g * 256 + c] * tr; }
            u32x2 w; w.x = pk2(v[0], v[1]); w.y = pk2(v[2], v[3]);
            *(u32x2*)(WCD + (size_t)r * 256 + lane * 4) = w;
            s1 = wave_sum(s1, lane); s2 = wave_sum(s2, lane);
            if (lane == 0) { C1CD[r] = s1; C2CD[r] = s2; }
        }
        for (size_t i = gt; i < (size_t)4096 * 2048 / 8; i += NGT) {
            const int R = (int)(i >> 8), s0 = (int)(i & 255) * 8 + 1; const bool isSin = (R >> 7) & 1; const int k = 1 + 128 * (R >> 8) + (R & 127);
            float v[8];
#pragma unroll
            for (int e = 0; e < 8; ++e) { const int sq = s0 + e; const int idx = (k * sq) & 4095; const float ang = (float)idx * (1.0f / 2048.0f);
                v[e] = (isSin ? -sinpif(ang) : cospif(ang)) * ((!isSin && sq == 2048) ? (0.5f / 1024.0f) : (1.0f / 1024.0f)); }
            u32x4 w; w.x = pk2(v[0], v[1]); w.y = pk2(v[2], v[3]); w.z = pk2(v[4], v[5]); w.w = pk2(v[6], v[7]);
            *(u32x4*)(DSEQ + i * 8) = w; }
    }
    __syncthreads();
    if (p.coop == 2) GSYNC_CG();
    GSYNC();

    for (int layer = 0; layer < 4; ++layer) {
        const int kind = layer % 3, jm = layer / 3;
        const float* ST2p = ST2;
        const float* g2p = ln2_g + (layer - 1) * DM; const float* b2p = ln2_b + (layer - 1) * DM;
        if (kind == 0) {
            bf16_t* ZA = H; bf16_t* GA = H + (size_t)2 * MT * DM;
            {
                if (layer == 0) { EpiAct<1, 2, false> E{ZA, 2048, ST2p, C1MIX, CBMIX, STV};
                    gemm_phase<0>(lds, wave_id, XB, AWIN, DM, DM, DM, MT / 256, 2048 / 256, E); }
                else { EpiAct<1, 2, true> E{ZA, 2048, ST2p, C1MIX + layer * 2048, CBMIX + layer * 2048, STV};
                    gemm_phase<0>(lds, wave_id, T2, AWIN + (size_t)jm * DM * 2048, DM, DM, DM, MT / 256, 2048 / 256, E); }
            }
            GSYNC();
            if (PHMASK & (1u << 21)) {
                FRESH_IDS();
                const int g = blk & 7;
                const int wq = wave >> 2, wcb = wave & 3, fr = lane & 15, fq = lane >> 4;
                const int qbase = wq * 64, cbase = wcb * 32;
                const bf16_t* Wsg = AWS + (size_t)(jm * 8 + g) * 16384;
                bf16x8 wsf[4][4];
#pragma unroll
                for (int jt = 0; jt < 4; ++jt)
#pragma unroll
                    for (int ks = 0; ks < 4; ++ks) wsf[jt][ks] = *(const bf16x8*)(Wsg + (size_t)(qbase + jt * 16 + fr) * 128 + ks * 32 + fq * 8);
                float wsr[4], bsr[4];
#pragma unroll
                for (int jt = 0; jt < 4; ++jt) { wsr[jt] = WSROW[(jm * 8 + g) * 128 + qbase + jt * 16 + fr]; bsr[jt] = a_b_s[(jm * 8 + g) * 128 + qbase + jt * 16 + fr]; }
                const int cch = g * 128 + cbase + fq * 8;
                const f32x4 lg0 = *(const f32x4*)(a_ln_g + jm * DM + cch), lg1 = *(const f32x4*)(a_ln_g + jm * DM + cch + 4);
                const f32x4 lb0 = *(const f32x4*)(a_ln_b + jm * DM + cch), lb1 = *(const f32x4*)(a_ln_b + jm * DM + cch + 4);
                LAS bf16_t* vT = (LAS bf16_t*)lds;
                for (int u = blk; u < 4096; u += G) {
                    const int chunk = u >> 3; const size_t tok0 = (size_t)chunk * 128;
#pragma unroll
                    for (int i = 0; i < 4; ++i) {
                        const int ch = tid + 512 * i, prow = ch >> 4, c8 = ch & 15;
                        const u32x4 w = *(const u32x4*)(ZA + (tok0 + prow) * 2048 + 1024 + g * 128 + c8 * 8);
                        f32x2 pt = *(const f32x2*)(STV + (tok0 + prow) * 8 + (tid & 3) * 2);
                        float s = pt.x, q = pt.y;
#pragma unroll
                        for (int o = 1; o < 4; o <<= 1) { s += shx(s, lane, o); q += shx(q, lane, o); }
                        const float mu = s * (1.0f / 1024.0f); const float rstd = __builtin_amdgcn_rsqf(fmaxf(q * (1.0f / 1024.0f) - mu * mu, 0.f) + LN_EPS);
                        const float e0 = (bf_lo(w.x) - mu) * rstd, e1 = (bf_hi(w.x) - mu) * rstd, e2 = (bf_lo(w.y) - mu) * rstd, e3 = (bf_hi(w.y) - mu) * rstd;
                        const float e4 = (bf_lo(w.z) - mu) * rstd, e5 = (bf_hi(w.z) - mu) * rstd, e6 = (bf_lo(w.w) - mu) * rstd, e7 = (bf_hi(w.w) - mu) * rstd;
                        const unsigned p01 = pk2(e0, e1), p23 = pk2(e2, e3), p45 = pk2(e4, e5), p67 = pk2(e6, e7);
                        LAS bf16_t* d = vT + (c8 * 8) * 136 + ((((prow >> 3) ^ c8) << 3) | (prow & 7));
                        d[0 * 136] = (bf16_t)(p01 & 0xffffu); d[1 * 136] = (bf16_t)(p01 >> 16); d[2 * 136] = (bf16_t)(p23 & 0xffffu); d[3 * 136] = (bf16_t)(p23 >> 16);
                        d[4 * 136] = (bf16_t)(p45 & 0xffffu); d[5 * 136] = (bf16_t)(p45 >> 16); d[6 * 136] = (bf16_t)(p67 & 0xffffu); d[7 * 136] = (bf16_t)(p67 >> 16);
                    }
                    __syncthreads();
                    f32x4 acc2[2][4];
#pragma unroll
                    for (int a = 0; a < 2; ++a)
#pragma unroll
                        for (int jt = 0; jt < 4; ++jt) acc2[a][jt] = (f32x4){0.f, 0.f, 0.f, 0.f};
#pragma unroll
                    for (int ks = 0; ks < 4; ++ks) {
#pragma unroll
                        for (int a = 0; a < 2; ++a) {
                            const int crow = cbase + 8 * (fr >> 2) + 4 * a + (fr & 3);
                            const bf16x8 xf = *(const LAS bf16x8*)(vT + crow * 136 + (((ks * 4 + fq) ^ ((crow >> 3) & 15)) << 3));
#pragma unroll
                            for (int jt = 0; jt < 4; ++jt) acc2[a][jt] = __builtin_amdgcn_mfma_f32_16x16x32_bf16(xf, wsf[jt][ks], acc2[a][jt], 0, 0, 0);
                        }
                    }
#pragma unroll
                    for (int jt = 0; jt < 4; ++jt) {
                        const size_t tok = tok0 + qbase + jt * 16 + fr;
                        const u32x4 uw = *(const u32x4*)(ZA + tok * 2048 + cch);
                        const f32x4 m0 = lg0 * acc2[0][jt] + lb0 * wsr[jt] + bsr[jt];
                        const f32x4 m1 = lg1 * acc2[1][jt] + lb1 * wsr[jt] + bsr[jt];
                        u32x4 o; o.x = pk2(bf_lo(uw.x) * m0[0], bf_hi(uw.x) * m0[1]); o.y = pk2(bf_lo(uw.y) * m0[2], bf_hi(uw.y) * m0[3]);
                        o.z = pk2(bf_lo(uw.z) * m1[0], bf_hi(uw.z) * m1[1]); o.w = pk2(bf_lo(uw.w) * m1[2], bf_hi(uw.w) * m1[3]);
                        *(u32x4*)(GA + tok * DM + cch) = o;
                    }
                    __syncthreads();
                }
            }
            GSYNC();
            {
                if (layer == 0) { EpiRes<true, false, false> E{XIN, T2, ST2p, g2p, b2p, nullptr, T1, nullptr, ST1};
                    gemm_phase<0>(lds, wave_id, GA, AWOUT, DM, DM, DM, MT / 256, DM / 256, E); }
                else { EpiRes<false, false, false> E{nullptr, T2, ST2p, g2p, b2p, nullptr, T1, nullptr, ST1};
                    gemm_phase<0>(lds, wave_id, GA, AWOUT + (size_t)jm * DM * DM, DM, DM, DM, MT / 256, DM / 256, E); }
            }
        } else if (kind == 1) {
            bf16_t* ZB = H; bf16_t* PT = H + (size_t)MT * DM; bf16_t* FB = H + (size_t)3 * MT * DM;
            {
                EpiAct<0, 1, true> E{ZB, DM, ST2p, C1MIX + layer * 2048, CBMIX + layer * 2048, STV};
                if (PHMASK & (1u << 2)) gemm_phase<0>(lds, wave_id, T2, BWIN, DM, DM, DM, MT / 256, DM / 256, E);
            }
            GSYNC();
            {
                {
                    FRESH_IDS();
                    const int o0 = gw * 8;
                    if (o0 < 16384) {
                        const int b = o0 >> 10, g = (o0 & 1023) >> 8, l0 = o0 & 255;
                        const size_t tok = (size_t)b * 4096;
                        const f32x2 sa = *(const f32x2*)(STV + tok * 8 + g * 2);
                        const float ssum = sa.x, sq = sa.y;
                        const float mu = ssum * (1.0f / 256.0f), rstd = __builtin_amdgcn_rsqf(fmaxf(sq * (1.0f / 256.0f) - mu * mu, 0.f) + LN_EPS);
                        const u32x2 zw = *(const u32x2*)(ZB + tok * DM + g * 256 + lane * 4);
                        const f32x4 lgv = *(const f32x4*)(b_ln_g + g * 256 + lane * 4), lbv = *(const f32x4*)(b_ln_b + g * 256 + lane * 4);
                        float zn[4] = {(bf_lo(zw.x) - mu) * rstd * lgv[0] + lbv[0], (bf_hi(zw.x) - mu) * rstd * lgv[1] + lbv[1], (bf_lo(zw.y) - mu) * rstd * lgv[2] + lbv[2], (bf_hi(zw.y) - mu) * rstd * lgv[3] + lbv[3]};
#pragma unroll 1
                        for (int t = 0; t < 8; ++t) { const int l = l0 + t; float acc_ = 0.f;
#pragma unroll
                            for (int e = 0; e < 4; ++e) { const int idx = (l * (lane * 4 + e)) & 255; acc_ += zn[e] * cospif((float)idx * (1.0f / 128.0f)); }
                            acc_ = wave_sum(acc_, lane); if (lane == 0) SIDE0[o0 + t] = acc_; }
                    }
                }
                EpiChanDft E{STV, C1CD, C2CD, PT};
                if (PHMASK & (1u << 3)) gemm_phase<1>(lds, wave_id, WCD, ZB, 256, DM, 256, 8, MT / 256, E);
            }
            GSYNC();
            {
                {
                    FRESH_IDS();
                    for (int o = gw; o < 16384; o += NGW) {
                        const bf16_t* pr = PT + (size_t)o * 4096 + lane * 32;
                        float acc_ = 0.f;
#pragma unroll
                        for (int c4 = 0; c4 < 4; ++c4) { const u32x4 w = *(const u32x4*)(pr + c4 * 8);
                            float last = bf_hi(w.w); if (c4 == 3 && lane == 63) last *= 0.5f;
                            acc_ += ((bf_lo(w.x) + bf_hi(w.x)) + (bf_lo(w.y) + bf_hi(w.y))) + ((bf_lo(w.z) + bf_hi(w.z)) + (bf_lo(w.w) + last)); }
                        acc_ = wave_sum(acc_, lane);
                        if (lane == 0) FB[((size_t)(o >> 10) * 4096) * DM + (o & 1023)] = (bf16_t)(pk2((acc_ + SIDE0[o]) * (1.0f / 1024.0f), 0.f) & 0xffffu);
                    }
                }
                EpiDftSym E{FB, SIDE0};
                if (PHMASK & (1u << 4)) gemm_phase<2>(lds, wave_id, DSEQ, PT, 2048, 4096, 2048, 256, 8, E);
            }
            GSYNC();
            {
                EpiRes<false, false, false> E{nullptr, T2, ST2p, g2p, b2p, nullptr, T1, nullptr, ST1};
                if (PHMASK & (1u << 5)) gemm_phase<0>(lds, wave_id, FB, BWOUT, DM, DM, DM, MT / 256, DM / 256, E);
            }
        } else {
            bf16_t* ZC = H; bf16_t* PC = H + (size_t)MT * DM; bf16_t* MC = H + (size_t)2 * MT * DM;
            {
                EpiAct<0, 0, true> E{ZC, DM, ST2p, C1MIX + layer * 2048, CBMIX + layer * 2048, nullptr};
                if (PHMASK & (1u << 6)) gemm_phase<0>(lds, wave_id, T2, CWIN, DM, DM, DM, MT / 256, DM / 256, E);
            }
            GSYNC();
            if (PHMASK & (1u << 22)) {
                FRESH_IDS();
                for (size_t task = gt; task < (size_t)(MT / 32) * 128; task += NGT) {
                    const int co = (int)(task & 127); const size_t seg = task >> 7;
                    const int gidx = co >> 5, w = 2 << gidx, half = w >> 1;
                    const size_t t0 = seg * 32; const int s0 = (int)(t0 & 4095); const size_t bbase = t0 - s0;
                    const bf16_t* zc = ZC + co * 8;
                    float sum[8];
#pragma unroll
                    for (int e = 0; e < 8; ++e) sum[e] = 0.f;
                    const int lo0 = s0 - half < 0 ? 0 : s0 - half, hi0 = s0 + half > SEQ ? SEQ : s0 + half;
                    for (int j = lo0; j < hi0; ++j) { const u32x4 v = *(const u32x4*)(zc + (bbase + j) * DM);
                        sum[0] += bf_lo(v.x); sum[1] += bf_hi(v.x); sum[2] += bf_lo(v.y); sum[3] += bf_hi(v.y); sum[4] += bf_lo(v.z); sum[5] += bf_hi(v.z); sum[6] += bf_lo(v.w); sum[7] += bf_hi(v.w); }
                    for (int i = 0; i < 32; ++i) {
                        const int s = s0 + i; const int lo = s - half < 0 ? 0 : s - half, hi = s + half > SEQ ? SEQ : s + half;
                        const float inv = 1.0f / (float)(hi - lo);
                        const u32x4 zc0 = *(const u32x4*)(zc + (bbase + s) * DM);
                        u32x4 o; o.x = pk2(sum[0] * inv - bf_lo(zc0.x), sum[1] * inv - bf_hi(zc0.x)); o.y = pk2(sum[2] * inv - bf_lo(zc0.y), sum[3] * inv - bf_hi(zc0.y));
                        o.z = pk2(sum[4] * inv - bf_lo(zc0.z), sum[5] * inv - bf_hi(zc0.z)); o.w = pk2(sum[6] * inv - bf_lo(zc0.w), sum[7] * inv - bf_hi(zc0.w));
                        *(u32x4*)(PC + (bbase + s) * DM + co * 8) = o;
                        if (s + half < SEQ) { const u32x4 v = *(const u32x4*)(zc + (bbase + s + half) * DM);
                            sum[0] += bf_lo(v.x); sum[1] += bf_hi(v.x); sum[2] += bf_lo(v.y); sum[3] += bf_hi(v.y); sum[4] += bf_lo(v.z); sum[5] += bf_hi(v.z); sum[6] += bf_lo(v.w); sum[7] += bf_hi(v.w); }
                        if (s - half >= 0) { const u32x4 v = *(const u32x4*)(zc + (bbase + s - half) * DM);
                            sum[0] -= bf_lo(v.x); sum[1] -= bf_hi(v.x); sum[2] -= bf_lo(v.y); sum[3] -= bf_hi(v.y); sum[4] -= bf_lo(v.z); sum[5] -= bf_hi(v.z); sum[6] -= bf_lo(v.w); sum[7] -= bf_hi(v.w); }
                    }
                }
            }
            __syncthreads();
            GSYNC();
            {
                EpiPlain E{MC, c_scale, nullptr};
                if (PHMASK & (1u << 7)) gemm_phase<3>(lds, wave_id, PC, CWG, DM, 256, 256, MT / 256, 4, E);
            }
            GSYNC();
            {
                EpiRes<false, false, false> E{nullptr, T2, ST2p, g2p, b2p, nullptr, T1, nullptr, ST1};
                if (PHMASK & (1u << 8)) gemm_phase<0>(lds, wave_id, MC, CWOUT, DM, DM, DM, MT / 256, DM / 256, E);
            }
        }
        GSYNC();
        constexpr int NCH = FFN_NCH, CHR = MT / NCH;
#define FFN1_CHUNK(ck_) do { const size_t r1 = (size_t)(ck_) * CHR; \
            EpiAct<2, 0, true> E1{H + (size_t)((ck_) & 1) * CHR * FF, FF, ST1 + r1 * 8, C1FFN + layer * FF, CBFFN + layer * FF, nullptr}; \
            gemm_phase<0>(lds, wave_id, T1 + r1 * DM, W1T + (size_t)layer * DM * FF, DM, DM, DM, CHR / 256, FF / 256, E1); } while (0)
        FFN1_CHUNK(0);
        GSYNC();
#pragma unroll 1
        for (int ck = 0; ck < NCH; ++ck) {
            const size_t r0 = (size_t)ck * CHR;
            const bf16_t* Hc = H + (size_t)(ck & 1) * CHR * FF;
            if (layer == 3) { EpiFinal E{T1 + r0 * DM, ST1 + r0 * 8, ln1_g + layer * DM, ln1_b + layer * DM, ffn_b2 + layer * DM, ln2_g + 3 * DM, ln2_b + 3 * DM, p.out + r0 * DM,
                                         (unsigned long long*)(WSP + WS_XBUF) + r0 * 4, (unsigned*)(WSP + WS_CNT) + (size_t)ck * (CHR / 256) * 64};
                gemm_phase<0>(lds, wave_id, Hc, W2T + (size_t)layer * DM * FF, FF, FF, FF, CHR / 256, DM / 256, E); }
            else { EpiRes<false, true, false> E{nullptr, T1 + r0 * DM, ST1 + r0 * 8, ln1_g + layer * DM, ln1_b + layer * DM, ffn_b2 + layer * DM, T2 + r0 * DM, nullptr, ST2 + r0 * 8};
                gemm_phase<0>(lds, wave_id, Hc, W2T + (size_t)layer * DM * FF, FF, FF, FF, CHR / 256, DM / 256, E); }
            if (ck < NCH - 1) FFN1_CHUNK(ck + 1);
            GSYNC();
        }
#undef FFN1_CHUNK
    }
}

extern "C" void kernel_launch(void* const* d_in, const int* in_sizes, int n_in, void* d_out, int out_size, void* d_ws, size_t ws_size, hipStream_t stream) {
    static int grid = 0;
    if (grid == 0) {
        int dev = 0, cus = 0, per_cu = 0;
        hipGetDevice(&dev);
        hipDeviceGetAttribute(&cus, hipDeviceAttributeMultiprocessorCount, dev);
        if (hipFuncSetAttribute((const void*)fwd_megakernel, hipFuncAttributeMaxDynamicSharedMemorySize, LDS_BYTES) != hipSuccess) { fprintf(stderr, "hipFuncSetAttribute failed\n"); grid = -1; return; }
        hipOccupancyMaxActiveBlocksPerMultiprocessor(&per_cu, (const void*)fwd_megakernel, NTHREADS, LDS_BYTES);
        if (per_cu < 1) { fprintf(stderr, "occupancy query says %d blocks per CU\n", per_cu); per_cu = 1; }
        grid = cus * 1;
        if (grid > 1024) grid = 1024;
        grid &= ~7;
        if (ws_size < WS_END) { fprintf(stderr, "workspace too small: %zu < %zu\n", ws_size, (size_t)WS_END); grid = -1; return; }
        (void)hipGetLastError();
    }
    if (grid < 0) return;
    (void)hipMemsetAsync((unsigned char*)d_ws + WS_BAR, 0, 16384 + 65536, stream);
    Params p{};
    for (int i = 0; i < 23; ++i) p.in[i] = (const float*)d_in[i];
    p.out = (float*)d_out; p.ws = (unsigned char*)d_ws; p.coop = 1; p.pad = 0;
    void* args[] = {&p};
    hipError_t e = hipLaunchCooperativeKernel((const void*)fwd_megakernel, dim3(grid), dim3(NTHREADS), args, LDS_BYTES, stream);
    if (e != hipSuccess) fprintf(stderr, "cooperative launch failed: %s (grid %d)\n", hipGetErrorString(e), grid);
}
```

```cpp
#include <hip/hip_runtime.h>
#include <hip/hip_cooperative_groups.h>
#include <cstdio>
namespace cg = cooperative_groups;

#define LAS __attribute__((address_space(3)))
typedef unsigned short bf16_t;
typedef short bf16x8 __attribute__((ext_vector_type(8)));
typedef float f32x4 __attribute__((ext_vector_type(4)));
typedef float f32x2 __attribute__((ext_vector_type(2)));
typedef unsigned u32x4 __attribute__((ext_vector_type(4)));
typedef unsigned u32x2 __attribute__((ext_vector_type(2)));

constexpr int MT = 65536, DM = 1024, FF = 4096, SEQ = 4096;
constexpr float ALPHA = 1.681792830507429f;
constexpr float LN_EPS = 1e-5f;
constexpr int NTHREADS = 512;
constexpr int LDS_STAGE = 131072;
constexpr int LDS_SPF = LDS_STAGE + 8256 + 2048;
constexpr int LDS_VEC = LDS_SPF + 8192;
constexpr int LDS_BYTES = LDS_VEC + 3072;
#ifndef FFN_NCH
#define FFN_NCH 4
#endif
#ifndef PHMASK
#define PHMASK 0xffffffffu
#endif

constexpr size_t MB128 = 134217728ull;
constexpr size_t WS_H = 0;
constexpr size_t WS_T1 = 4 * MB128;
constexpr size_t WS_T2 = 5 * MB128;
constexpr size_t WS_W = 6 * MB128;
constexpr size_t W_W1T = WS_W;
constexpr size_t W_W2T = W_W1T + 33554432ull;
constexpr size_t W_AWIN = W_W2T + 33554432ull;
constexpr size_t W_AWOUT = W_AWIN + 8388608ull;
constexpr size_t W_AWS = W_AWOUT + 4194304ull;
constexpr size_t W_BWIN = W_AWS + 524288ull;
constexpr size_t W_BWOUT = W_BWIN + 2097152ull;
constexpr size_t W_CWIN = W_BWOUT + 2097152ull;
constexpr size_t W_CWOUT = W_CWIN + 2097152ull;
constexpr size_t W_CWG = W_CWOUT + 2097152ull;
constexpr size_t W_WCD = W_CWG + 524288ull;
constexpr size_t W_DSEQ = W_WCD + 1048576ull;
constexpr size_t WS_VEC = W_DSEQ + 67108864ull;
constexpr size_t V_C1FFN = WS_VEC;
constexpr size_t V_CBFFN = V_C1FFN + 65536;
constexpr size_t V_C1MIX = V_CBFFN + 65536;
constexpr size_t V_CBMIX = V_C1MIX + 32768;
constexpr size_t V_C1CD = V_CBMIX + 32768;
constexpr size_t V_C2CD = V_C1CD + 8192;
constexpr size_t V_WSROW = V_C2CD + 8192;
constexpr size_t V_SIDE0 = V_WSROW + 8192;
constexpr size_t WS_ST1 = V_SIDE0 + 65536;
constexpr size_t WS_ST2 = WS_ST1 + 8388608ull;
constexpr size_t WS_STV = WS_ST2 + 8388608ull;
constexpr size_t WS_BAR = WS_STV + 8388608ull;
constexpr size_t WS_CNT = WS_BAR + 16384;
constexpr size_t WS_XBUF = WS_CNT + 65536;
constexpr size_t WS_END = WS_XBUF + 2097152ull;

struct Params { const float* in[23]; float* out; unsigned char* ws; int coop; int pad; };

constexpr int BM = 256, BK = 64, HALF = 128, HTB = HALF * BK * 2, NXCD = 8, WGM = 8;
__device__ __forceinline__ unsigned pk2(float lo, float hi) { unsigned r; asm("v_cvt_pk_bf16_f32 %0, %1, %2" : "=v"(r) : "v"(lo), "v"(hi)); return r; }
__device__ __forceinline__ float bf_lo(unsigned w) { return __uint_as_float(w << 16); }
__device__ __forceinline__ float bf_hi(unsigned w) { return __uint_as_float(w & 0xffff0000u); }
__device__ __forceinline__ float bf_round(float x) { unsigned u = __float_as_uint(x); u += 0x7fffu + ((u >> 16) & 1u); return __uint_as_float(u & 0xffff0000u); }
__device__ __forceinline__ float shx(float v, int lane, int o) { return __int_as_float(__builtin_amdgcn_ds_bpermute((lane ^ o) << 2, __float_as_int(v))); }
__device__ __forceinline__ float wave_sum(float v, int lane) {
#pragma unroll
    for (int o = 1; o < 64; o <<= 1) v += shx(v, lane, o);
    return v;
}
__device__ __forceinline__ float gelu_tanh(float x) {
    const float t = x * (1.0f + 0.044715f * x * x);
    const float e = __builtin_amdgcn_exp2f(-2.302208198f * t);
    return x * __builtin_amdgcn_rcpf(1.0f + e);
}
#define UP(T, base, ub, lb) ((T*)((const char*)(base) + (size_t)(ub) + (unsigned)(lb)))
__device__ __forceinline__ void row_stats4(const float* ST, int urow, int fr, int fq, float& mu, float& rstd) {
    const f32x2 a = *UP(const f32x2, ST, (size_t)urow * 32, fr * 32 + fq * 8);
    float s = a.x, q = a.y;
    const int ln = fq * 16 + fr;
    s += shx(s, ln, 16); s += shx(s, ln, 32); q += shx(q, ln, 16); q += shx(q, ln, 32);
    mu = s * (1.0f / 1024.0f);
    const float var = fmaxf(q * (1.0f / 1024.0f) - mu * mu, 0.0f);
    rstd = __builtin_amdgcn_rsqf(var + LN_EPS);
}
__device__ __forceinline__ void row_stats4_lds(LAS unsigned char* sp, int rl, float& mu, float& rstd) {
    const f32x4 a = *(const LAS f32x4*)(sp + rl * 32), b = *(const LAS f32x4*)(sp + rl * 32 + 16);
    const float s = (a.x + a.z) + (b.x + b.z), q = (a.y + a.w) + (b.y + b.w);
    mu = s * (1.0f / 1024.0f);
    rstd = __builtin_amdgcn_rsqf(fmaxf(q * (1.0f / 1024.0f) - mu * mu, 0.0f) + LN_EPS);
}
__device__ __forceinline__ void stats_publish(LAS unsigned char* xl, float* STO, int pm, int slot, int wr, int wc, int fr, int fq) {
    asm volatile("s_waitcnt lgkmcnt(0)" ::: "memory"); __builtin_amdgcn_s_barrier(); asm volatile("" ::: "memory");
    if (fq == 0) {
#pragma unroll
        for (int ai = 0; ai < 2; ++ai) {
            const int rl = ai * HALF + wr * 64 + wc * 16 + fr;
            const f32x4 a = *(const LAS f32x4*)(xl + rl * 32), b = *(const LAS f32x4*)(xl + rl * 32 + 16);
            *(f32x2*)(STO + (size_t)(pm * BM + rl) * 8 + slot * 2) = (f32x2){(a.x + a.z) + (b.x + b.z), (a.y + a.w) + (b.y + b.w)};
        }
    }
}

#define XB_TMO      128
#define XB_XCNT(j)  (256  + 64 * (j))
#define XB_XSUB(j)  (1280 + 64 * (j))
#define XB_XGEN(j)  (2304 + 64 * (j))
#define XB_TOP      3328
#define XB_TOPGEN   3392
#define XCD_BAR_WORDS 3456
#define XB_SPIN_CAP (1u << 20)
__device__ __forceinline__ unsigned xb_ld(unsigned* p)              { return __hip_atomic_load(p, __ATOMIC_RELAXED, __HIP_MEMORY_SCOPE_AGENT); }
__device__ __forceinline__ unsigned xb_add(unsigned* p, unsigned v) { return __hip_atomic_fetch_add(p, v, __ATOMIC_RELAXED, __HIP_MEMORY_SCOPE_AGENT); }
__device__ __forceinline__ unsigned xb_xcc_id() { return (unsigned)__builtin_amdgcn_s_getreg((3 << 11) | 20) & 0xFu; }
#define XB_SPIN(cond, bar) do { unsigned _sp = 0; while (cond) { __builtin_amdgcn_s_sleep(1); \
    if ((++_sp & 255u) == 0u) { if (xb_ld(&(bar)[XB_TMO])) break; if (_sp > XB_SPIN_CAP) { atomicAdd(&(bar)[XB_TMO], 1u); break; } } } } while (0)
__device__ __forceinline__ void xcd_barrier_complete(unsigned* bar, unsigned x, unsigned& nloc, unsigned& nx) {
    const unsigned G = gridDim.x * gridDim.y * gridDim.z;
    unsigned sum, cnt, mine, sp = 0u;
    for (;;) {
        sum = 0u; cnt = 0u;
#pragma unroll 1
        for (unsigned j = 0; j < 16; ++j) { const unsigned c = xb_ld(&bar[XB_XCNT(j)]); sum += c; cnt += (c > 0u) ? 1u : 0u; }
        mine = xb_ld(&bar[XB_XCNT(x)]);
        if (sum == G) break;
        __builtin_amdgcn_s_sleep(1);
        if ((++sp & 255u) == 0u) { if (xb_ld(&bar[XB_TMO])) break; if (sp > XB_SPIN_CAP) { atomicAdd(&bar[XB_TMO], 1u); break; } }
    }
    nloc = mine > 0u ? mine : 1u; nx = cnt > 0u ? cnt : 1u;
}
__device__ __forceinline__ void xcd_barrier(unsigned* bar, unsigned x, volatile LAS unsigned* st, bool is_t0) {
    asm volatile("s_waitcnt vmcnt(0)" ::: "memory");
    __syncthreads();
    if (is_t0) {
        __builtin_amdgcn_s_waitcnt(0);
        unsigned nloc = st[0], nx = st[1];
        if (nloc == 0u) { xcd_barrier_complete(bar, x, nloc, nx); st[0] = nloc; st[1] = nx; }
        const unsigned old = xb_add(&bar[XB_XSUB(x)], 1u);
        const unsigned gen = old / nloc;
        if (old + 1u == (gen + 1u) * nloc) {
            __builtin_amdgcn_fence(__ATOMIC_RELEASE, "agent");
            asm volatile("s_waitcnt vmcnt(0)" ::: "memory");
            const unsigned og = xb_add(&bar[XB_TOP], 1u);
            const unsigned tg = og / nx;
            if (og + 1u == (tg + 1u) * nx) xb_add(&bar[XB_TOPGEN], 1u);
            else XB_SPIN(xb_ld(&bar[XB_TOPGEN]) == tg, bar);
            __builtin_amdgcn_fence(__ATOMIC_ACQUIRE, "agent");
            asm volatile("s_waitcnt vmcnt(0)" ::: "memory");
        } else {
            XB_SPIN(xb_ld(&bar[XB_TOPGEN]) == gen, bar);
            __builtin_amdgcn_fence(__ATOMIC_ACQUIRE, "agent");
            asm volatile("s_waitcnt vmcnt(0)" ::: "memory");
        }
    }
    __syncthreads();
}

__device__ __forceinline__ int lds_byte(int r, int c) { const int st = (r >> 4) * 2 + (c >> 5), rr = r & 15, cc = c & 31, ob = rr * 64 + cc * 2; return st * 1024 + (ob ^ (((ob >> 9) & 1) << 5)); }
__device__ __forceinline__ void stage_rc(int b, int& R, int& C) { const int st = b / 1024, sb = b % 1024, swz = sb ^ (((sb >> 9) & 1) << 5); R = (st >> 1) * 16 + swz / 64; C = (st & 1) * 32 + (swz % 64) / 2; }
__device__ __forceinline__ int perm32(int rho) { const int n = rho >> 4, i = rho & 15; return 8 * (i >> 2) + 4 * n + (i & 3); }

struct Unit { int pm, pn; };
__device__ __forceinline__ bool unit_next(int i, int nM, int nN, int G, int c, Unit& u) {
    const int nwg = nM * nN;
    const long L = (long)i * G + c; if (L >= nwg) return false;
    int wgid = (int)L; { const int q = nwg / NXCD, r = nwg % NXCD, xcd = wgid % NXCD, off = wgid / NXCD; wgid = (xcd < r ? xcd * (q + 1) : r * (q + 1) + (xcd - r) * q) + off; }
    const int nig = WGM * nN, gid = wgid / nig, fm = gid * WGM, gsz = (nM - fm) < WGM ? (nM - fm) : WGM;
    u.pm = fm + ((wgid % nig) % gsz); u.pn = (wgid % nig) / gsz; return true;
}
template <int GM> __device__ __forceinline__ void unit_off(const Unit& u, int lda, int ldb, size_t& ao, size_t& bo, size_t& bo1) {
    if (GM == 0) { ao = (size_t)u.pm * 256 * lda * 2; bo = (size_t)u.pn * 256 * ldb * 2; }
    if (GM == 1) { ao = (size_t)u.pm * 256 * lda * 2; const int b = u.pn >> 4, j = u.pn & 15;
        bo = ((size_t)(b * 4096 + 1 + 128 * j) * ldb + (size_t)(u.pm >> 1) * 256) * 2; bo1 = ((size_t)(b * 4096 + 3968 - 128 * j) * ldb + (size_t)(u.pm >> 1) * 256) * 2; }
    if (GM == 2) { ao = (size_t)(u.pm & 15) * 256 * lda * 2; bo = ((size_t)(u.pm >> 4) * 1024 + (size_t)u.pn * 256) * ldb * 2; bo1 = bo + 4096; }
    if (GM == 3) { ao = ((size_t)u.pm * 256 * lda + (size_t)u.pn * 256) * 2; bo = (size_t)u.pn * 256 * ldb * 2; }
    if (GM != 1 && GM != 2) bo1 = bo + (size_t)HALF * ldb * 2;
}

template <int GM, bool REV = false, class Epi>
__device__ __forceinline__ void gemm_phase(LAS unsigned char* lds, int wave_id, const bf16_t* Ab, const bf16_t* Bb, int lda, int ldb, int K, int nM, int nN, const Epi& E) {
    unsigned z_ = 0u; asm volatile("" : "+v"(z_));   int tid_ = wave_id * 64 + (int)__builtin_amdgcn_mbcnt_hi(~0u, __builtin_amdgcn_mbcnt_lo(~0u, z_));
    const int tid = tid_, wid = __builtin_amdgcn_readfirstlane(tid >> 6), lane = tid & 63, wr = wid >> 2, wc = wid & 3, fr = lane & 15, fq = lane >> 4;
    const int nt = K / BK; const int G = gridDim.x, cblk = blockIdx.x;
    constexpr bool MIR = (GM == 1);
    unsigned voffA, voffB, voffBm;
    { int R, C; stage_rc(tid * 16, R, C); const int Rb = (R & ~31) + perm32(R & 31);
        voffA = (unsigned)(R * lda + C) * 2u; voffB = (unsigned)(Rb * ldb + C) * 2u; voffBm = MIR ? (unsigned)((127 - Rb) * ldb + C) * 2u : voffB + ((GM == 2 && Rb == 0) ? (unsigned)(128 * ldb * 2 - 4096) : 0u); }
    const long r64A = (long)64 * lda * 2, r64B = (long)64 * ldb * 2;
    const size_t kstep = (size_t)(BK * 2);
    const size_t hstepA = (size_t)HALF * lda * 2, hstepB = (GM == 2) ? (size_t)4096 : (size_t)HALF * ldb * 2;
    constexpr bool SKIPX = (GM == 2);
    const unsigned ldsw = (unsigned)wid * 1024u;
    const int aoff = lds_byte(wr * 64 + fr, fq * 8), boff = lds_byte(wc * 32 + fr, fq * 8);
#define PG8_SA(b, h) (((b) * 2 + (h)) * HTB)
#define PG8_SB(b, h) ((4 + (b) * 2 + (h)) * HTB)
#define PG8_STAGE_(bufoff, gbase, voff, r64) do { _Pragma("unroll") for (int _i = 0; _i < 2; ++_i) { const char* g_ = (const char*)(gbase) + (long)_i * (r64); asm volatile("" : "+s"(g_));   \
        __builtin_amdgcn_global_load_lds((const unsigned*)(g_ + (voff)), (LAS unsigned*)(lds + (bufoff) + ldsw + _i * 8192), 16, 0, 0); } } while (0)
#define PG8_STAGE(bufoff, gbase, voff) PG8_STAGE_##voff(bufoff, gbase)
#define PG8_STAGE_voffA(bufoff, gbase) PG8_STAGE_(bufoff, gbase, voffA, r64A)
#define PG8_STAGE_voffB(bufoff, gbase) PG8_STAGE_(bufoff, gbase, voffB, r64B)
#define PG8_STAGE1_(bufoff, gbase, voff, i_) do { const char* g_ = (const char*)(gbase) + (long)(i_) * r64B; asm volatile("" : "+s"(g_)); \
        __builtin_amdgcn_global_load_lds((const unsigned*)(g_ + (voff)), (LAS unsigned*)(lds + (bufoff) + ldsw + (i_) * 8192), 16, 0, 0); } while (0)
#define PG8_STAGEB1(bufoff, gbase) do { if (MIR) PG8_STAGE_(bufoff, gbase, voffBm, -r64B); else if (GM == 2) { PG8_STAGE1_(bufoff, gbase, voffBm, 0); PG8_STAGE1_(bufoff, gbase, voffB, 1); } \
        else PG8_STAGE_(bufoff, gbase, voffB, r64B); } while (0)
#define PG8_LDA(dst, b, h) do { _Pragma("unroll") for (int m = 0; m < 4; ++m) _Pragma("unroll") for (int k = 0; k < 2; ++k) dst[m][k] = *(const LAS bf16x8*)(lds + PG8_SA(b, h) + aoff + m * 2048 + k * 1024); } while (0)
#define PG8_LDB(dst, b, h) do { _Pragma("unroll") for (int n = 0; n < 2; ++n) _Pragma("unroll") for (int k = 0; k < 2; ++k) dst[n][k] = *(const LAS bf16x8*)(lds + PG8_SB(b, h) + boff + n * 2048 + k * 1024); } while (0)
#define PG8_MMA(ai, bj, At, Bt) do { __builtin_amdgcn_s_setprio(1); _Pragma("unroll") for (int m = 0; m < 4; ++m) _Pragma("unroll") for (int n = 0; n < 2; ++n) _Pragma("unroll") for (int k = 0; k < 2; ++k) \
        acc[ai][bj][m][n] = __builtin_amdgcn_mfma_f32_16x16x32_bf16(Bt[n][k], At[m][k], acc[ai][bj][m][n], 0, 0, 0); __builtin_amdgcn_s_setprio(0); } while (0)
#define PG8_WAIT_V(n) asm volatile("s_waitcnt vmcnt(" #n ")" ::: "memory")
#define PG8_WAIT_L(n) asm volatile("s_waitcnt lgkmcnt(" #n ")" ::: "memory")
#define PG8_BAR __builtin_amdgcn_s_barrier()
#define PG8_SCHED __builtin_amdgcn_sched_barrier(0)
    Unit cur, nxt; int ui = 0;
#define PG8_RI(i) (REV ? ((nM * nN + G - 1) / G - 1 - (i)) : (i))
    (void)unit_next(PG8_RI(0), nM, nN, G, cblk, cur);
    f32x4 acc[2][2][4][2];
#pragma unroll
    for (int a = 0; a < 2; ++a)
#pragma unroll
        for (int b = 0; b < 2; ++b)
#pragma unroll
            for (int m = 0; m < 4; ++m)
#pragma unroll
                for (int n = 0; n < 2; ++n) acc[a][b][m][n] = (f32x4){0.f, 0.f, 0.f, 0.f};
    bf16x8 At[4][2], B0[2][2], B1[2][2];
    size_t ao, bo, bo1; unit_off<GM>(cur, lda, ldb, ao, bo, bo1);
    const char* cA = (const char*)Ab + ao; const char* cB = (const char*)Bb + bo; const char* cB1 = (const char*)Bb + bo1;
    PG8_STAGE(PG8_SB(0, 0), cB, voffB); PG8_STAGE(PG8_SA(0, 0), cA, voffA); PG8_STAGEB1(PG8_SB(0, 1), cB1); PG8_STAGE(PG8_SA(0, 1), cA + hstepA, voffA);
    if (wr == 1) PG8_BAR;
    PG8_WAIT_V(4); PG8_BAR;
    PG8_STAGE(PG8_SB(1, 0), cB + kstep, voffB); PG8_STAGE(PG8_SA(1, 0), cA + kstep, voffA); PG8_STAGEB1(PG8_SB(1, 1), cB1 + kstep);
    PG8_WAIT_V(6); PG8_BAR;
    for (;;) {
        const bool has_next = (!REV || ui + 1 < (nM * nN + G - 1) / G) && unit_next(PG8_RI(ui + 1), nM, nN, G, cblk, nxt);
        const char* nA = cA; const char* nB = cB; const char* nB1 = cB1;
        if (has_next) { unit_off<GM>(nxt, lda, ldb, ao, bo, bo1); nA = (const char*)Ab + ao; nB = (const char*)Bb + bo; nB1 = (const char*)Bb + bo1; }
#pragma unroll 1
        for (int t = 0; t < nt; t += 2) {
            const bool last = (t == nt - 2);
            if (Epi::SPF) { if (last) {
                const char* sp_ = (const char*)E.spf_src() + (size_t)cur.pm * 8192 + (size_t)wid * 1024; asm volatile("" : "+s"(sp_));
                const unsigned lo_ = (unsigned)__builtin_amdgcn_mbcnt_hi(~0u, __builtin_amdgcn_mbcnt_lo(~0u, 0u)) * 16u;
                __builtin_amdgcn_global_load_lds((const unsigned*)(sp_ + lo_), (LAS unsigned*)(lds + LDS_SPF + ldsw), 16, 0, 0); } }
            if (Epi::NVEC > 0) { if (last) {
                const unsigned lo4_ = (unsigned)__builtin_amdgcn_mbcnt_hi(~0u, __builtin_amdgcn_mbcnt_lo(~0u, 0u)) * 4u;
                const size_t vo_ = ((size_t)E.vec_off(cur.pm, cur.pn) + (size_t)(wid & 3) * 64) * 4;
#define PG8_VEC(k_) do { const char* vp_ = (const char*)E.vec_src(k_) + vo_; asm volatile("" : "+s"(vp_)); \
                    __builtin_amdgcn_global_load_lds((const unsigned*)(vp_ + lo4_), (LAS unsigned*)(lds + LDS_VEC + (k_) * 1024 + (wid & 3) * 256), 4, 0, 0); } while (0)
                if (wid < 4) { PG8_VEC(0); if (Epi::NVEC > 2) PG8_VEC(2); }
                else { if (Epi::NVEC > 1) PG8_VEC(1); }
#undef PG8_VEC
            } }
            const char* a1 = cA + (size_t)(t + 1) * kstep;
            const char* a2 = last ? nA : cA + (size_t)(t + 2) * kstep; const char* b2 = last ? nB : cB + (size_t)(t + 2) * kstep;
            const char* a3 = a2 + kstep; const char* b3 = b2 + kstep;
            const char* b2h = MIR ? (last ? nB1 : cB1 + (size_t)(t + 2) * kstep) : b2 + hstepB; const char* b3h = b2h + kstep;
            PG8_LDB(B0, 0, 0); PG8_SCHED; PG8_LDA(At, 0, 0); PG8_STAGE(PG8_SA(1, 1), a1 + hstepA, voffA);
            PG8_WAIT_L(8); PG8_BAR; PG8_WAIT_L(0); PG8_MMA(0, 0, At, B0); PG8_BAR; PG8_SCHED;
            PG8_LDB(B1, 0, 1); PG8_STAGE(PG8_SB(0, 0), b2, voffB);
            PG8_BAR; PG8_WAIT_L(0); if (!SKIPX) PG8_MMA(0, 1, At, B1);
            if (SKIPX) { if (wc == 0) { __builtin_amdgcn_s_setprio(1); _Pragma("unroll") for (int m = 0; m < 4; ++m) _Pragma("unroll") for (int k = 0; k < 2; ++k)
                acc[0][1][m][0] = __builtin_amdgcn_mfma_f32_16x16x32_bf16(B1[0][k], At[m][k], acc[0][1][m][0], 0, 0, 0); __builtin_amdgcn_s_setprio(0); } }
            PG8_BAR;
            PG8_LDA(At, 0, 1); PG8_STAGE(PG8_SA(0, 0), a2, voffA);
            PG8_BAR; PG8_WAIT_L(0); if (!SKIPX) PG8_MMA(1, 0, At, B0); PG8_BAR; PG8_SCHED;
            PG8_STAGEB1(PG8_SB(0, 1), b2h);
            PG8_WAIT_V(6); PG8_BAR; PG8_MMA(1, 1, At, B1); PG8_BAR;
            PG8_LDB(B0, 1, 0); PG8_SCHED; PG8_LDA(At, 1, 0); PG8_STAGE(PG8_SA(0, 1), a2 + hstepA, voffA);
            PG8_WAIT_L(8); PG8_BAR; PG8_WAIT_L(0); PG8_MMA(0, 0, At, B0); PG8_BAR; PG8_SCHED;
            PG8_LDB(B1, 1, 1); PG8_STAGE(PG8_SB(1, 0), b3, voffB);
            PG8_BAR; PG8_WAIT_L(0); if (!SKIPX) PG8_MMA(0, 1, At, B1);
            if (SKIPX) { if (wc == 0) { __builtin_amdgcn_s_setprio(1); _Pragma("unroll") for (int m = 0; m < 4; ++m) _Pragma("unroll") for (int k = 0; k < 2; ++k)
                acc[0][1][m][0] = __builtin_amdgcn_mfma_f32_16x16x32_bf16(B1[0][k], At[m][k], acc[0][1][m][0], 0, 0, 0); __builtin_amdgcn_s_setprio(0); } }
            PG8_BAR;
            PG8_LDA(At, 1, 1); PG8_STAGE(PG8_SA(1, 0), a3, voffA);
            PG8_BAR; PG8_WAIT_L(0); if (!SKIPX) PG8_MMA(1, 0, At, B0); PG8_BAR; PG8_SCHED;
            PG8_STAGEB1(PG8_SB(1, 1), b3h);
            PG8_WAIT_V(6); PG8_BAR; PG8_MMA(1, 1, At, B1); PG8_BAR;
        }
        if constexpr (!Epi::AFTER_DRAIN) { int pm_ = cur.pm, pn_ = cur.pn, ln_ = lane;
          asm volatile("" : "+s"(pm_), "+s"(pn_), "+v"(ln_));
          E(acc, pm_, pn_, wr, wc, ln_ & 15, ln_ >> 4, lds + LDS_STAGE); }
        if (!has_next) break;
#pragma unroll
        for (int a = 0; a < 2; ++a)
#pragma unroll
            for (int b = 0; b < 2; ++b)
#pragma unroll
                for (int m = 0; m < 4; ++m)
#pragma unroll
                    for (int n = 0; n < 2; ++n) acc[a][b][m][n] = (f32x4){0.f, 0.f, 0.f, 0.f};
        cur = nxt; cA = nA; cB = nB; cB1 = nB1; ++ui;
    }
    PG8_WAIT_V(0);
    if (wr == 0) PG8_BAR;
    PG8_BAR;
    if constexpr (Epi::AFTER_DRAIN) { int pm_ = cur.pm, pn_ = cur.pn, ln_ = lane;
        asm volatile("" : "+s"(pm_), "+s"(pn_), "+v"(ln_));
        E(acc, pm_, pn_, wid, wr, wc, ln_ & 15, ln_ >> 4, lds + LDS_STAGE); }
#undef PG8_SA
#undef PG8_SB
#undef PG8_STAGE
#undef PG8_STAGE_
#undef PG8_STAGE_voffA
#undef PG8_STAGE_voffB
#undef PG8_STAGEB1
#undef PG8_STAGE1_
#undef PG8_LDA
#undef PG8_LDB
#undef PG8_MMA
#undef PG8_WAIT_V
#undef PG8_WAIT_L
#undef PG8_BAR
#undef PG8_SCHED
#undef PG8_RI
}


template <int ACT, int STATS, bool FOLD> struct EpiAct {
    static constexpr bool AFTER_DRAIN = false, SPF = FOLD; static constexpr int NVEC = FOLD ? 2 : 0;
    __device__ __forceinline__ const float* spf_src() const { return ST; }
    __device__ __forceinline__ const float* vec_src(int k) const { return k ? cb : c1; }
    __device__ __forceinline__ int vec_off(int pm, int pn) const { return pn * 256; }
    bf16_t* O; int ldc; const float* ST; const float* c1; const float* cb; float* STO;
    __device__ __forceinline__ void operator()(const f32x4 (&acc)[2][2][4][2], int pm, int pn, int wr, int wc, int fr, int fq, LAS unsigned char* xl) const {
        const int urow0 = pm * BM + wr * 64, ucol0 = pn * BM + wc * 32;
        const unsigned lst = (unsigned)(fr * ldc + fq * 8) * 2u;
        constexpr bool fold = FOLD;
        f32x4 vc1[2][2], vcb[2][2];
#pragma unroll
        for (int bj = 0; bj < 2; ++bj)
#pragma unroll
            for (int n = 0; n < 2; ++n) {
                const int vo = (wc * 32 + bj * HALF + n * 4 + fq * 8) * 4;
                vc1[bj][n] = fold ? *(const LAS f32x4*)(xl + (LDS_VEC - LDS_STAGE) + vo) : (f32x4){0.f, 0.f, 0.f, 0.f};
                vcb[bj][n] = fold ? *(const LAS f32x4*)(xl + (LDS_VEC - LDS_STAGE) + 1024 + vo) : (f32x4){0.f, 0.f, 0.f, 0.f}; }
        const bool dostats = (STATS == 1) || (STATS == 2 && pn >= 4);
        const int slot = (STATS == 2 ? (pn - 4) : pn);
#pragma unroll
        for (int ai = 0; ai < 2; ++ai)
#pragma unroll
            for (int m = 0; m < 4; ++m) {
                const int urow = urow0 + ai * HALF + m * 16;
                float mu = 0.f, rstd = 1.f;
                if (fold) row_stats4_lds(xl + (LDS_SPF - LDS_STAGE), ai * HALF + wr * 64 + m * 16 + fr, mu, rstd);
                float s = 0.f, q = 0.f;
#pragma unroll
                for (int bj = 0; bj < 2; ++bj) {
                    f32x4 v0 = acc[ai][bj][m][0], v1 = acc[ai][bj][m][1];
                    v0 = (v0 - mu * vc1[bj][0]) * rstd + vcb[bj][0];
                    v1 = (v1 - mu * vc1[bj][1]) * rstd + vcb[bj][1];
                    if (ACT == 1) {
#pragma unroll
                        for (int j = 0; j < 4; ++j) { v0[j] = gelu_tanh(v0[j]); v1[j] = gelu_tanh(v1[j]); } }
                    if (ACT == 2) {
#pragma unroll
                        for (int j = 0; j < 4; ++j) { v0[j] = fmaxf(v0[j], 0.f); v1[j] = fmaxf(v1[j], 0.f); }
                        v0 = v0 * v0; v1 = v1 * v1; }
                    if (STATS != 0) {
                        s += ((v0[0] + v0[1]) + (v0[2] + v0[3])) + ((v1[0] + v1[1]) + (v1[2] + v1[3]));
                        q += ((v0[0] * v0[0] + v0[1] * v0[1]) + (v0[2] * v0[2] + v0[3] * v0[3])) + ((v1[0] * v1[0] + v1[1] * v1[1]) + (v1[2] * v1[2] + v1[3] * v1[3])); }
                    u32x4 w; w.x = pk2(v0[0], v0[1]); w.y = pk2(v0[2], v0[3]); w.z = pk2(v1[0], v1[1]); w.w = pk2(v1[2], v1[3]);
                    *UP(u32x4, O, ((size_t)urow * ldc + ucol0 + bj * HALF) * 2, lst) = w;
                }
                if (STATS != 0) {
                    if (dostats) {
                        const int ln = fq * 16 + fr; s += shx(s, ln, 16); s += shx(s, ln, 32); q += shx(q, ln, 16); q += shx(q, ln, 32);
                        if (fq == 0) *(LAS f32x2*)(xl + (ai * HALF + wr * 64 + m * 16 + fr) * 32 + wc * 8) = (f32x2){s, q};
                    } }
                asm volatile("" ::: "memory");
            }
        if (STATS != 0) { if (dostats) stats_publish(xl, STO, pm, slot, wr, wc, fr, fq); }
    }
};

template <bool RAW, bool BIAS, bool F32> struct EpiRes {
    static constexpr bool AFTER_DRAIN = false, SPF = !RAW; static constexpr int NVEC = RAW ? 0 : (BIAS ? 3 : 2);
    __device__ __forceinline__ const float* spf_src() const { return STp; }
    __device__ __forceinline__ const float* vec_src(int k) const { return k == 0 ? g : (k == 1 ? b : bias); }
    __device__ __forceinline__ int vec_off(int pm, int pn) const { return pn * 256; }
    const float* xraw; const bf16_t* tprev; const float* STp; const float* g; const float* b; const float* bias;
    bf16_t* O; float* Of; float* STO;
    __device__ __forceinline__ void operator()(const f32x4 (&acc)[2][2][4][2], int pm, int pn, int wr, int wc, int fr, int fq, LAS unsigned char* xl) const {
        const int urow0 = pm * BM + wr * 64, ucol0 = pn * BM + wc * 32;
        const unsigned l16 = (unsigned)(fr * DM + fq * 8) * 2u, l32 = (unsigned)(fr * DM + fq * 8) * 4u;
        constexpr bool raw = RAW;
        f32x4 vg[2][2], vb[2][2];
#pragma unroll
        for (int bj = 0; bj < 2; ++bj)
#pragma unroll
            for (int n = 0; n < 2; ++n) {
                const int vo = (wc * 32 + bj * HALF + n * 4 + fq * 8) * 4;
                vg[bj][n] = raw ? (f32x4){1.f, 1.f, 1.f, 1.f} : *(const LAS f32x4*)(xl + (LDS_VEC - LDS_STAGE) + vo);
                vb[bj][n] = raw ? (f32x4){0.f, 0.f, 0.f, 0.f} : ALPHA * *(const LAS f32x4*)(xl + (LDS_VEC - LDS_STAGE) + 1024 + vo);
                if (BIAS) vb[bj][n] += *(const LAS f32x4*)(xl + (LDS_VEC - LDS_STAGE) + 2048 + vo); }
        constexpr int LA = RAW ? 1 : 2;
        u32x4 tq[8][2]; f32x4 xq[8][2][2];
#define RES_ISSUE(r_) do { const int ai_ = (r_) >> 2, m_ = (r_) & 3; _Pragma("unroll") for (int bj = 0; bj < 2; ++bj) { \
            const size_t uo_ = (size_t)(urow0 + ai_ * HALF + m_ * 16) * DM + ucol0 + bj * HALF; \
            if (raw) { xq[r_][bj][0] = *UP(const f32x4, xraw, uo_ * 4, l32); xq[r_][bj][1] = *UP(const f32x4, xraw, uo_ * 4 + 16, l32); } \
            else tq[r_][bj] = *UP(const u32x4, tprev, uo_ * 2, l16); } } while (0)
#pragma unroll
        for (int r = 0; r < LA; ++r) RES_ISSUE(r);
#pragma unroll
        for (int r = 0; r < 8; ++r) {
                const int ai = r >> 2, m = r & 3;
                if (r + LA < 8) RES_ISSUE(r + LA);
                float mu = 0.f, rstd = 1.f;
                if (!raw) row_stats4_lds(xl + (LDS_SPF - LDS_STAGE), ai * HALF + wr * 64 + m * 16 + fr, mu, rstd);
                float s = 0.f, q = 0.f;
#pragma unroll
                for (int bj = 0; bj < 2; ++bj) {
                    const size_t uoff = (size_t)(urow0 + ai * HALF + m * 16) * DM + ucol0 + bj * HALF;
                    f32x4 r0, r1;
                    if (raw) { r0 = xq[r][bj][0]; r1 = xq[r][bj][1]; }
                    else { const u32x4 w = tq[r][bj];
                        r0 = (f32x4){bf_lo(w.x), bf_hi(w.x), bf_lo(w.y), bf_hi(w.y)}; r1 = (f32x4){bf_lo(w.z), bf_hi(w.z), bf_lo(w.w), bf_hi(w.w)}; }
                    const float ars = ALPHA * rstd;
                    const f32x4 v0 = (r0 - mu) * ars * vg[bj][0] + (acc[ai][bj][m][0] + vb[bj][0]);
                    const f32x4 v1 = (r1 - mu) * ars * vg[bj][1] + (acc[ai][bj][m][1] + vb[bj][1]);
                    s += ((v0[0] + v0[1]) + (v0[2] + v0[3])) + ((v1[0] + v1[1]) + (v1[2] + v1[3]));
                    q += ((v0[0] * v0[0] + v0[1] * v0[1]) + (v0[2] * v0[2] + v0[3] * v0[3])) + ((v1[0] * v1[0] + v1[1] * v1[1]) + (v1[2] * v1[2] + v1[3] * v1[3]));
                    if (F32) { *UP(f32x4, Of, uoff * 4, l32) = v0; *UP(f32x4, Of, uoff * 4 + 16, l32) = v1; }
                    else { u32x4 w; w.x = pk2(v0[0], v0[1]); w.y = pk2(v0[2], v0[3]); w.z = pk2(v1[0], v1[1]); w.w = pk2(v1[2], v1[3]); *UP(u32x4, O, uoff * 2, l16) = w; }
                }
                const int ln = fq * 16 + fr; s += shx(s, ln, 16); s += shx(s, ln, 32); q += shx(q, ln, 16); q += shx(q, ln, 32);
                if (fq == 0) *(LAS f32x2*)(xl + (ai * HALF + wr * 64 + m * 16 + fr) * 32 + wc * 8) = (f32x2){s, q};
                asm volatile("" ::: "memory");
            }
#undef RES_ISSUE
        stats_publish(xl, STO, pm, pn, wr, wc, fr, fq);
    }
};

struct EpiFinal {
    static constexpr bool AFTER_DRAIN = true, SPF = false; static constexpr int NVEC = 0;
    __device__ __forceinline__ const float* spf_src() const { return nullptr; }
    __device__ __forceinline__ const float* vec_src(int) const { return nullptr; }
    __device__ __forceinline__ int vec_off(int, int) const { return 0; }
    const bf16_t* tprev; const float* STp; const float* g; const float* b; const float* bias; const float* g2; const float* b2;
    float* Of; unsigned long long* xbuf; unsigned* cnt;
    __device__ __forceinline__ void operator()(f32x4 (&acc)[2][2][4][2], int pm, int pn, int wid, int wr, int wc, int fr, int fq, LAS unsigned char* xl) const {
        const int urow0 = pm * BM + wr * 64, ucol0 = pn * BM + wc * 32;
        const unsigned l16 = (unsigned)(fr * DM + fq * 8) * 2u, l32 = (unsigned)(fr * DM + fq * 8) * 4u;
        const int ln = fq * 16 + fr;
        LAS f32x2* S = (LAS f32x2*)(xl + 8256);
        {
            f32x4 vg[2][2], vb[2][2];
#pragma unroll
            for (int bj = 0; bj < 2; ++bj)
#pragma unroll
                for (int n = 0; n < 2; ++n) { const int uc = (ucol0 + bj * HALF + n * 4) * 4;
                    vg[bj][n] = *UP(const f32x4, g, uc, fq * 32); vb[bj][n] = ALPHA * *UP(const f32x4, b, uc, fq * 32) + *UP(const f32x4, bias, uc, fq * 32); }
            float mu8[2][4], rs8[2][4];
#pragma unroll
            for (int ai = 0; ai < 2; ++ai)
#pragma unroll
                for (int m = 0; m < 4; ++m) row_stats4(STp, urow0 + ai * HALF + m * 16, fr, fq, mu8[ai][m], rs8[ai][m]);
#pragma unroll
            for (int ai = 0; ai < 2; ++ai)
#pragma unroll
                for (int m = 0; m < 4; ++m) {
                    const float mu = mu8[ai][m], ars = ALPHA * rs8[ai][m];
                    float s = 0.f, q = 0.f;
#pragma unroll
                    for (int bj = 0; bj < 2; ++bj) {
                        const size_t uoff = (size_t)(urow0 + ai * HALF + m * 16) * DM + ucol0 + bj * HALF;
                        const u32x4 w = *UP(const u32x4, tprev, uoff * 2, l16);
                        const f32x4 r0 = (f32x4){bf_lo(w.x), bf_hi(w.x), bf_lo(w.y), bf_hi(w.y)}, r1 = (f32x4){bf_lo(w.z), bf_hi(w.z), bf_lo(w.w), bf_hi(w.w)};
                        const f32x4 v0 = (r0 - mu) * ars * vg[bj][0] + (acc[ai][bj][m][0] + vb[bj][0]);
                        const f32x4 v1 = (r1 - mu) * ars * vg[bj][1] + (acc[ai][bj][m][1] + vb[bj][1]);
                        s += ((v0[0] + v0[1]) + (v0[2] + v0[3])) + ((v1[0] + v1[1]) + (v1[2] + v1[3]));
                        q += ((v0[0] * v0[0] + v0[1] * v0[1]) + (v0[2] * v0[2] + v0[3] * v0[3])) + ((v1[0] * v1[0] + v1[1] * v1[1]) + (v1[2] * v1[2] + v1[3] * v1[3]));
                        acc[ai][bj][m][0] = v0; acc[ai][bj][m][1] = v1;
                    }
                    s += shx(s, ln, 16); s += shx(s, ln, 32); q += shx(q, ln, 16); q += shx(q, ln, 32);
                    if (fq == 0) *(LAS f32x2*)(xl + (ai * HALF + wr * 64 + m * 16 + fr) * 32 + wc * 8) = (f32x2){s, q};
                    if (m & 1) asm volatile("" ::: "memory");
                }
        }
        asm volatile("s_waitcnt lgkmcnt(0)" ::: "memory"); __builtin_amdgcn_s_barrier(); asm volatile("" ::: "memory");
        const int rl = wid * 32 + (ln & 31);
        if (ln < 32) {
            const f32x4 a = *(const LAS f32x4*)(xl + rl * 32), c = *(const LAS f32x4*)(xl + rl * 32 + 16);
            const float s = (a.x + a.z) + (c.x + c.z), q = (a.y + a.w) + (c.y + c.w);
            __hip_atomic_store(xbuf + ((size_t)(pm * BM + rl) * 4 + pn), ((unsigned long long)__float_as_uint(q) << 32) | __float_as_uint(s), __ATOMIC_RELAXED, __HIP_MEMORY_SCOPE_AGENT);
        }
        asm volatile("s_waitcnt vmcnt(0)" ::: "memory");
        if (ln == 0) __hip_atomic_fetch_add(cnt + 64 * pm, 1u, __ATOMIC_RELAXED, __HIP_MEMORY_SCOPE_AGENT);
        if (wid == 0) {
            unsigned sp = 0;
            while ((unsigned)__builtin_amdgcn_readfirstlane(__hip_atomic_load(cnt + 64 * pm, __ATOMIC_RELAXED, __HIP_MEMORY_SCOPE_AGENT)) < 32u) { __builtin_amdgcn_s_sleep(1); if (++sp > (1u << 22)) break; }
            __builtin_amdgcn_fence(__ATOMIC_ACQUIRE, "agent");
            asm volatile("s_waitcnt vmcnt(0)" ::: "memory");
        }
        asm volatile("s_waitcnt vmcnt(0) lgkmcnt(0)" ::: "memory"); __builtin_amdgcn_s_barrier(); asm volatile("" ::: "memory");
        if (ln < 32) {
            const unsigned long long* slot = xbuf + (size_t)(pm * BM + rl) * 4; float s = 0.f, q = 0.f;
#pragma unroll
            for (int t = 0; t < 4; ++t) { const unsigned long long w = __hip_atomic_load(slot + t, __ATOMIC_RELAXED, __HIP_MEMORY_SCOPE_AGENT); s += __uint_as_float((unsigned)w); q += __uint_as_float((unsigned)(w >> 32)); }
            const float mu = s * (1.0f / 1024.0f); const float var = fmaxf(q * (1.0f / 1024.0f) - mu * mu, 0.f);
            S[rl] = (f32x2){mu, __builtin_amdgcn_rsqf(var + LN_EPS)};
        }
        asm volatile("s_waitcnt lgkmcnt(0)" ::: "memory"); __builtin_amdgcn_s_barrier(); asm volatile("" ::: "memory");
        f32x4 wg2[2][2], wb2[2][2];
#pragma unroll
        for (int bj = 0; bj < 2; ++bj)
#pragma unroll
            for (int n = 0; n < 2; ++n) { const int uc = (ucol0 + bj * HALF + n * 4) * 4; wg2[bj][n] = *UP(const f32x4, g2, uc, fq * 32); wb2[bj][n] = *UP(const f32x4, b2, uc, fq * 32); }
#pragma unroll
        for (int ai = 0; ai < 2; ++ai)
#pragma unroll
            for (int m = 0; m < 4; ++m) {
                const f32x2 sr = S[ai * HALF + wr * 64 + m * 16 + fr];
#pragma unroll
                for (int bj = 0; bj < 2; ++bj) {
                    const size_t uoff = (size_t)(urow0 + ai * HALF + m * 16) * DM + ucol0 + bj * HALF;
                    *UP(f32x4, Of, uoff * 4, l32) = (acc[ai][bj][m][0] - sr.x) * sr.y * wg2[bj][0] + wb2[bj][0];
                    *UP(f32x4, Of, uoff * 4 + 16, l32) = (acc[ai][bj][m][1] - sr.x) * sr.y * wg2[bj][1] + wb2[bj][1];
                }
            }
    }
};

struct EpiChanDft {
    static constexpr bool AFTER_DRAIN = false, SPF = false; static constexpr int NVEC = 2;
    __device__ __forceinline__ const float* spf_src() const { return nullptr; }
    __device__ __forceinline__ const float* vec_src(int k) const { return k ? c2 : c1; }
    __device__ __forceinline__ int vec_off(int pm, int pn) const { return pm * 256; }
    const float* STV; const float* c1; const float* c2; bf16_t* PT;
    __device__ __forceinline__ void operator()(f32x4 (&acc)[2][2][4][2], int pm, int pn, int wr, int wc, int fr, int fq, LAS unsigned char* xl) const {
        const int g = pm >> 1, part = pm & 1;
        const int bidx = pn >> 4, j = pn & 15;
        const int r0 = wc * 32 + fq * 8;
        const float sgn = part ? -1.0f : 1.0f;
        float kk[8];
#pragma unroll
        for (int bj = 0; bj < 2; ++bj) {
            float rs[8];
#pragma unroll
            for (int e = 0; e < 8; ++e) {
                const int tok = bidx * 4096 + (bj ? (4095 - 128 * j - r0 - e) : (1 + 128 * j + r0 + e));
                const f32x2 a = *(const f32x2*)(STV + (size_t)tok * 8 + g * 2);
                const float m_ = a.x * (1.0f / 256.0f); const float var = fmaxf(a.y * (1.0f / 256.0f) - m_ * m_, 0.f);
                rs[e] = __builtin_amdgcn_rsqf(var + LN_EPS);
                kk[e] = bj ? kk[e] + sgn * m_ * rs[e] : m_ * rs[e]; }
#pragma unroll
            for (int ai = 0; ai < 2; ++ai)
#pragma unroll
                for (int m = 0; m < 4; ++m)
#pragma unroll
                    for (int e = 0; e < 4; ++e) { acc[ai][bj][m][0][e] *= rs[e]; acc[ai][bj][m][1][e] *= rs[4 + e]; }
            asm volatile("" ::: "memory");
        }
#pragma unroll
        for (int ai = 0; ai < 2; ++ai)
#pragma unroll
            for (int m = 0; m < 4; ++m) {
                const int l = ai * HALF + wr * 64 + m * 16 + fr;
                const float cc1 = *(const LAS float*)(xl + (LDS_VEC - LDS_STAGE) + l * 4), cc2 = (1.0f + sgn) * *(const LAS float*)(xl + (LDS_VEC - LDS_STAGE) + 1024 + l * 4);
                bf16_t* rowp = PT + ((size_t)(bidx * 1024 + g * 256 + l) * 4096 + part * 2048 + 128 * j + r0);
                f32x4 v0 = acc[ai][0][m][0] + sgn * acc[ai][1][m][0] + cc2, v1 = acc[ai][0][m][1] + sgn * acc[ai][1][m][1] + cc2;
#pragma unroll
                for (int e = 0; e < 4; ++e) { v0[e] -= cc1 * kk[e]; v1[e] -= cc1 * kk[4 + e]; }
                u32x4 w; w.x = pk2(v0[0], v0[1]); w.y = pk2(v0[2], v0[3]); w.z = pk2(v1[0], v1[1]); w.w = pk2(v1[2], v1[3]);
                *(u32x4*)rowp = w;
                asm volatile("" ::: "memory");
            }
    }
};

struct EpiDftSym {
    static constexpr bool AFTER_DRAIN = false, SPF = false; static constexpr int NVEC = 0;
    __device__ __forceinline__ const float* spf_src() const { return nullptr; }
    __device__ __forceinline__ const float* vec_src(int) const { return nullptr; }
    __device__ __forceinline__ int vec_off(int, int) const { return 0; }
    bf16_t* O; const float* side;
    static __device__ __forceinline__ void store_mirror(bf16_t* rowp, int bc, bool has0, const f32x4& v0, const f32x4& v1) {
        *(bf16_t*)(rowp + bc + 1) = (bf16_t)(pk2(v1[3], 0.f) & 0xffffu);
        *(unsigned*)(rowp + bc + 2) = pk2(v1[2], v1[1]);
        u32x2 w; w.x = pk2(v1[0], v0[3]); w.y = pk2(v0[2], v0[1]);
        *(u32x2*)(rowp + bc + 4) = w;
        if (has0) *(bf16_t*)(rowp + bc + 8) = (bf16_t)(pk2(v0[0], 0.f) & 0xffffu);
    }
    __device__ __forceinline__ void operator()(const f32x4 (&acc)[2][2][4][2], int pm, int pn, int wr, int wc, int fr, int fq, LAS unsigned char* xl) const {
        const int b = pm >> 4, kt = pm & 15, g = pn;
        const int l0 = wc * 32 + fq * 8;
        const int ucol0 = g * 256 + wc * 32;
        f32x4 vsd[2];
#pragma unroll
        for (int n = 0; n < 2; ++n) vsd[n] = *UP(const f32x4, side, (b * 1024 + ucol0 + n * 4) * 4, fq * 32) * (1.0f / 1024.0f);
        const float sd128 = side[b * 1024 + g * 256 + 128] * (1.0f / 1024.0f);
        const int bc = g * 256 + 248 - l0;
#pragma unroll
        for (int m = 0; m < 4; ++m) {
            const int k = 1 + 128 * kt + wr * 64 + m * 16 + fr;
            bf16_t* r1 = O + ((size_t)b * 4096 + k) * DM; bf16_t* r2 = O + ((size_t)b * 4096 + (4096 - k)) * DM;
            const f32x4 c0 = acc[0][0][m][0] + vsd[0], c1 = acc[0][0][m][1] + vsd[1], s1 = acc[1][1][m][1]; f32x4 s0 = acc[1][1][m][0];
            if (l0 == 0) s0[0] = 0.f;
            const f32x4 p0 = c0 + s0, p1 = c1 + s1, q0 = c0 - s0, q1 = c1 - s1;
            u32x4 w; w.x = pk2(p0[0], p0[1]); w.y = pk2(p0[2], p0[3]); w.z = pk2(p1[0], p1[1]); w.w = pk2(p1[2], p1[3]);
            *(u32x4*)(r1 + ucol0 + fq * 8) = w;
            u32x4 z; z.x = pk2(q0[0], q0[1]); z.y = pk2(q0[2], q0[3]); z.z = pk2(q1[0], q1[1]); z.w = pk2(q1[2], q1[3]);
            *(u32x4*)(r2 + ucol0 + fq * 8) = z;
            store_mirror(r1, bc, l0 != 0, q0, q1);
            store_mirror(r2, bc, l0 != 0, p0, p1);
            if (wc == 0 && fq == 0) { const bf16_t v = (bf16_t)(pk2(acc[0][1][m][0][0] + sd128, 0.f) & 0xffffu);
                r1[g * 256 + 128] = v; r2[g * 256 + 128] = v; }
            asm volatile("" ::: "memory");
        }
    }
};

struct EpiPlain {
    static constexpr bool AFTER_DRAIN = false, SPF = false; static constexpr int NVEC = 0;
    __device__ __forceinline__ const float* spf_src() const { return nullptr; }
    __device__ __forceinline__ const float* vec_src(int) const { return nullptr; }
    __device__ __forceinline__ int vec_off(int, int) const { return 0; }
    bf16_t* O; const float* scale; const float* side;
    __device__ __forceinline__ void operator()(const f32x4 (&acc)[2][2][4][2], int pm, int pn, int wr, int wc, int fr, int fq, LAS unsigned char* xl) const {
        const int urow0 = pm * BM + wr * 64, ucol0 = pn * BM + wc * 32;
        const unsigned l16 = (unsigned)(fr * DM + fq * 8) * 2u;
        f32x4 vs[2][2], vsd[2][2];
#pragma unroll
        for (int bj = 0; bj < 2; ++bj)
#pragma unroll
            for (int n = 0; n < 2; ++n) { vs[bj][n] = scale ? *UP(const f32x4, scale, (ucol0 + bj * HALF + n * 4) * 4, fq * 32) : (f32x4){1.f, 1.f, 1.f, 1.f};
                vsd[bj][n] = side ? *UP(const f32x4, side, ((pm >> 4) * 1024 + ucol0 + bj * HALF + n * 4) * 4, fq * 32) * (1.0f / 1024.0f) : (f32x4){0.f, 0.f, 0.f, 0.f}; }
#pragma unroll
        for (int ai = 0; ai < 2; ++ai)
#pragma unroll
            for (int m = 0; m < 4; ++m) {
#pragma unroll
                for (int bj = 0; bj < 2; ++bj) {
                    const f32x4 v0 = acc[ai][bj][m][0] * vs[bj][0] + vsd[bj][0], v1 = acc[ai][bj][m][1] * vs[bj][1] + vsd[bj][1];
                    u32x4 w; w.x = pk2(v0[0], v0[1]); w.y = pk2(v0[2], v0[3]); w.z = pk2(v1[0], v1[1]); w.w = pk2(v1[2], v1[3]);
                    *UP(u32x4, O, ((size_t)(urow0 + ai * HALF + m * 16) * DM + ucol0 + bj * HALF) * 2, l16) = w;
                }
                asm volatile("" ::: "memory");
            }
    }
};

__device__ __forceinline__ void tr_item(const float* W, int K, int N, bf16_t* WT, const float* gk, LAS float* scr, int item, int lane) {
    const int nblk = N / 32, kb = item / nblk, nb = item % nblk, k0 = 64 * kb, n0 = 32 * nb;
#pragma unroll 8
    for (int i = 0; i < 32; ++i) { const int kk = 2 * i + (lane >> 5); float w = W[(size_t)(k0 + kk) * N + n0 + (lane & 31)]; if (gk) w *= gk[k0 + kk]; scr[kk * 33 + (lane & 31)] = w; }
    asm volatile("s_waitcnt lgkmcnt(0)" ::: "memory");
    const int c = lane & 7;
#pragma unroll
    for (int j = 0; j < 4; ++j) { const int n = (lane >> 3) + 8 * j; const LAS float* s = scr + (8 * c) * 33 + n;
        u32x4 o; o.x = pk2(s[0 * 33], s[1 * 33]); o.y = pk2(s[2 * 33], s[3 * 33]); o.z = pk2(s[4 * 33], s[5 * 33]); o.w = pk2(s[6 * 33], s[7 * 33]);
        *(u32x4*)(WT + (size_t)(n0 + n) * K + k0 + 8 * c) = o; }
    asm volatile("s_waitcnt lgkmcnt(0)" ::: "memory");
}
__device__ __forceinline__ void colsum_item(const float* W, int K, int N, const float* g, const float* b, const float* bias, float* c1, float* cb, int item, int lane) {
    const int n = item * 64 + lane; float s1 = 0.f, s2 = 0.f;
#pragma unroll 32
    for (int k = 0; k < K; ++k) { const float w = W[(size_t)k * N + n]; s1 += bf_round(g[k] * w); s2 += b[k] * w; }
    c1[n] = s1; cb[n] = s2 + (bias ? bias[n] : 0.f);
}

__global__ void __launch_bounds__(NTHREADS) fwd_megakernel(Params p) {
    extern __shared__ __attribute__((aligned(16))) unsigned char lds_raw[];
    LAS unsigned char* lds = (LAS unsigned char*)lds_raw;
    cg::grid_group grid = cg::this_grid();
    const int G = gridDim.x, blk = blockIdx.x;
    const int NGW = G * 8; const size_t NGT = (size_t)G * NTHREADS;
    const int wave_id = __builtin_amdgcn_readfirstlane(threadIdx.x >> 6);
#define FRESH_IDS() unsigned z_ = 0u; asm volatile("" : "+v"(z_));   int tid_ = wave_id * 64 + (int)__builtin_amdgcn_mbcnt_hi(~0u, __builtin_amdgcn_mbcnt_lo(~0u, z_)); const int tid = tid_, lane = tid & 63, wave = __builtin_amdgcn_readfirstlane(tid >> 6); \
    const int gw = blk * 8 + wave; const size_t gt = (size_t)blk * NTHREADS + tid; (void)gw; (void)gt; (void)lane;
#define GAS __attribute__((address_space(1)))
#define WSP ([&]() { unsigned long long w_ = (unsigned long long)p.ws; asm volatile("" : "+s"(w_)); return (unsigned char*)(GAS unsigned char*)w_; }())
    const unsigned xcc = xb_xcc_id();
    { FRESH_IDS();
      if (tid < 4) ((volatile LAS unsigned*)(lds + LDS_STAGE + 8192))[tid] = 0u;
      __syncthreads();
      if (tid == 0) (void)xb_add(&((unsigned*)(WSP + WS_BAR))[XB_XCNT(xcc)], 1u); }
#define GSYNC_CG() do { if (p.coop) grid.sync(); } while (0)
#define GSYNC() do { if (p.coop) { FRESH_IDS(); xcd_barrier((unsigned*)(WSP + WS_BAR), xcc, (volatile LAS unsigned*)(lds + LDS_STAGE + 8192), tid == 0); } } while (0)
#define XIN (p.in[0])
#define ln1_g (p.in[1])
#define ln1_b (p.in[2])
#define ffn_w1 (p.in[3])
#define ffn_b1 (p.in[4])
#define ffn_w2 (p.in[5])
#define ffn_b2 (p.in[6])
#define ln2_g (p.in[7])
#define ln2_b (p.in[8])
#define a_w_in (p.in[9])
#define a_ln_g (p.in[10])
#define a_ln_b (p.in[11])
#define a_w_s (p.in[12])
#define a_b_s (p.in[13])
#define a_w_out (p.in[14])
#define b_w_in (p.in[15])
#define b_ln_g (p.in[16])
#define b_ln_b (p.in[17])
#define b_w_out (p.in[18])
#define c_w_in (p.in[19])
#define c_w_grp (p.in[20])
#define c_scale (p.in[21])
#define c_w_out (p.in[22])
#define H ((bf16_t*)(WSP + WS_H))
#define T1 ((bf16_t*)(WSP + WS_T1))
#define T2 ((bf16_t*)(WSP + WS_T2))
#define XB ((bf16_t*)(WSP + WS_T2))
#define W1T ((bf16_t*)(WSP + W_W1T))
#define W2T ((bf16_t*)(WSP + W_W2T))
#define AWIN ((bf16_t*)(WSP + W_AWIN))
#define AWOUT ((bf16_t*)(WSP + W_AWOUT))
#define AWS ((bf16_t*)(WSP + W_AWS))
#define BWIN ((bf16_t*)(WSP + W_BWIN))
#define BWOUT ((bf16_t*)(WSP + W_BWOUT))
#define CWIN ((bf16_t*)(WSP + W_CWIN))
#define CWOUT ((bf16_t*)(WSP + W_CWOUT))
#define CWG ((bf16_t*)(WSP + W_CWG))
#define WCD ((bf16_t*)(WSP + W_WCD))
#define DSEQ ((bf16_t*)(WSP + W_DSEQ))
#define C1FFN ((float*)(WSP + V_C1FFN))
#define CBFFN ((float*)(WSP + V_CBFFN))
#define C1MIX ((float*)(WSP + V_C1MIX))
#define CBMIX ((float*)(WSP + V_CBMIX))
#define C1CD ((float*)(WSP + V_C1CD))
#define C2CD ((float*)(WSP + V_C2CD))
#define WSROW ((float*)(WSP + V_WSROW))
#define SIDE0 ((float*)(WSP + V_SIDE0))
#define ST1 ((float*)(WSP + WS_ST1))
#define ST2 ((float*)(WSP + WS_ST2))
#define STV ((float*)(WSP + WS_STV))

#ifndef P0_REP
#define P0_REP 1
#endif
#pragma unroll 1
    for (int rep0 = 0; rep0 < P0_REP; ++rep0) {
        FRESH_IDS();
        for (size_t i = gt; i < (size_t)MT * DM / 8; i += NGT) {
            const f32x4 a = *(const f32x4*)(XIN + i * 8), b = *(const f32x4*)(XIN + i * 8 + 4);
            u32x4 w; w.x = pk2(a[0], a[1]); w.y = pk2(a[2], a[3]); w.z = pk2(b[0], b[1]); w.w = pk2(b[2], b[3]);
            *(u32x4*)(XB + i * 8) = w; }
        {
            LAS float* scr = (LAS float*)(lds + wave * 8448);
            constexpr int I_W1 = (DM / 64) * (FF / 32), I_W2 = (FF / 64) * (DM / 32), I_AIN = (DM / 64) * (2048 / 32), I_SQ = (DM / 64) * (DM / 32), I_G = (256 / 64) * (256 / 32);
            constexpr int NITEMS = 4 * I_W1 + 4 * I_W2 + 2 * I_AIN + 2 * I_SQ + 4 * I_SQ + 4 * I_G;
            for (int it = gw; it < NITEMS; it += NGW) {
                int r = it;
                if (r < 4 * I_W1) { const int l = r / I_W1; tr_item(ffn_w1 + (size_t)l * DM * FF, DM, FF, W1T + (size_t)l * DM * FF, ln1_g + l * DM, scr, r % I_W1, lane); continue; } r -= 4 * I_W1;
                if (r < 4 * I_W2) { const int l = r / I_W2; tr_item(ffn_w2 + (size_t)l * DM * FF, FF, DM, W2T + (size_t)l * DM * FF, nullptr, scr, r % I_W2, lane); continue; } r -= 4 * I_W2;
                if (r < 2 * I_AIN) { const int l = r / I_AIN; tr_item(a_w_in + (size_t)l * DM * 2048, DM, 2048, AWIN + (size_t)l * DM * 2048, l ? ln2_g + 2 * DM : nullptr, scr, r % I_AIN, lane); continue; } r -= 2 * I_AIN;
                if (r < 2 * I_SQ) { const int l = r / I_SQ; tr_item(a_w_out + (size_t)l * DM * DM, DM, DM, AWOUT + (size_t)l * DM * DM, nullptr, scr, r % I_SQ, lane); continue; } r -= 2 * I_SQ;
                if (r < I_SQ) { tr_item(b_w_in, DM, DM, BWIN, ln2_g + 0 * DM, scr, r, lane); continue; } r -= I_SQ;
                if (r < I_SQ) { tr_item(b_w_out, DM, DM, BWOUT, nullptr, scr, r, lane); continue; } r -= I_SQ;
                if (r < I_SQ) { tr_item(c_w_in, DM, DM, CWIN, ln2_g + 1 * DM, scr, r, lane); continue; } r -= I_SQ;
                if (r < I_SQ) { tr_item(c_w_out, DM, DM, CWOUT, nullptr, scr, r, lane); continue; } r -= I_SQ;
                { const int l = r / I_G; tr_item(c_w_grp + (size_t)l * 65536, 256, 256, CWG + (size_t)l * 65536, nullptr, scr, r % I_G, lane); }
            }
        }
        {
            constexpr int J_FFN = FF / 64, J_A = 2048 / 64, J_S = DM / 64;
            constexpr int NJ = 4 * J_FFN + J_A + 2 * J_S;
            for (int it = wave * G + blk; it < NJ; it += NGW) {
                int r = it;
                if (r < 4 * J_FFN) { const int l = r / J_FFN; colsum_item(ffn_w1 + (size_t)l * DM * FF, DM, FF, ln1_g + l * DM, ln1_b + l * DM, ffn_b1 + l * FF, C1FFN + l * FF, CBFFN + l * FF, r % J_FFN, lane); continue; } r -= 4 * J_FFN;
                if (r < J_A) { colsum_item(a_w_in + (size_t)DM * 2048, DM, 2048, ln2_g + 2 * DM, ln2_b + 2 * DM, nullptr, C1MIX + 3 * 2048, CBMIX + 3 * 2048, r, lane); continue; } r -= J_A;
                if (r < J_S) { colsum_item(b_w_in, DM, DM, ln2_g + 0 * DM, ln2_b + 0 * DM, nullptr, C1MIX + 1 * 2048, CBMIX + 1 * 2048, r, lane); continue; } r -= J_S;
                colsum_item(c_w_in, DM, DM, ln2_g + 1 * DM, ln2_b + 1 * DM, nullptr, C1MIX + 2 * 2048, CBMIX + 2 * 2048, r, lane);
            }
        }
        for (size_t i = gt; i < 262144; i += NGT) AWS[i] = (bf16_t)(pk2(a_w_s[i], 0.f) & 0xffffu);
        for (int r = gw; r < 2048; r += NGW) { const float s = wave_sum(a_w_s[(size_t)r * 128 + lane] + a_w_s[(size_t)r * 128 + 64 + lane], lane); if (lane == 0) WSROW[r] = s; }
        for (int r = gw; r < 2048; r += NGW) {
            const int g = r >> 9, part = (r >> 8) & 1, l = r & 255;
            float s1 = 0.f, s2 = 0.f; float v[4];
#pragma unroll
            for (int e = 0; e < 4; ++e) { const int c = lane * 4 + e; const int idx = (l * c) & 255; const float ang = (float)idx * (1.0f / 128.0f);
                const float tr = part ? sinpif(ang) : cospif(ang); const float gv = b_ln_g[g * 256 + c] * tr; v[e] = gv; s1 += bf_round(gv); s2 += b_ln_b[g * 256 + c] * tr; }
            u32x2 w; w.x = pk2(v[0], v[1]); w.y = pk2(v[2], v[3]);
            *(u32x2*)(WCD + (size_t)r * 256 + lane * 4) = w;
            s1 = wave_sum(s1, lane); s2 = wave_sum(s2, lane);
            if (lane == 0) { C1CD[r] = s1; C2CD[r] = s2; }
        }
        for (size_t i = gt; i < (size_t)4096 * 2048 / 8; i += NGT) {
            const int R = (int)(i >> 8), s0 = (int)(i & 255) * 8 + 1; const bool isSin = (R >> 7) & 1; const int k = 1 + 128 * (R >> 8) + (R & 127);
            float v[8];
#pragma unroll
            for (int e = 0; e < 8; ++e) { const int sq = s0 + e; const int idx = (k * sq) & 4095; const float ang = (float)idx * (1.0f / 2048.0f);
                v[e] = (isSin ? -sinpif(ang) : cospif(ang)) * ((!isSin && sq == 2048) ? (0.5f / 1024.0f) : (1.0f / 1024.0f)); }
            u32x4 w; w.x = pk2(v[0], v[1]); w.y = pk2(v[2], v[3]); w.z = pk2(v[4], v[5]); w.w = pk2(v[6], v[7]);
            *(u32x4*)(DSEQ + i * 8) = w; }
    }
    __syncthreads();
    if (p.coop == 2) GSYNC_CG();
    GSYNC();

    for (int layer = 0; layer < 4; ++layer) {
        const int kind = layer % 3, jm = layer / 3;
        const float* ST2p = ST2;
        const float* g2p = ln2_g + (layer - 1) * DM; const float* b2p = ln2_b + (layer - 1) * DM;
        if (kind == 0) {
            bf16_t* ZA = H; bf16_t* GA = H + (size_t)2 * MT * DM;
            {
                if (layer == 0) { EpiAct<1, 2, false> E{ZA, 2048, ST2p, C1MIX, CBMIX, STV};
                    gemm_phase<0>(lds, wave_id, XB, AWIN, DM, DM, DM, MT / 256, 2048 / 256, E); }
                else { EpiAct<1, 2, true> E{ZA, 2048, ST2p, C1MIX + layer * 2048, CBMIX + layer * 2048, STV};
                    gemm_phase<0>(lds, wave_id, T2, AWIN + (size_t)jm * DM * 2048, DM, DM, DM, MT / 256, 2048 / 256, E); }
            }
            GSYNC();
            if (PHMASK & (1u << 21)) {
                FRESH_IDS();
                const int g = blk & 7;
                const int wq = wave >> 2, wcb = wave & 3, fr = lane & 15, fq = lane >> 4;
                const int qbase = wq * 64, cbase = wcb * 32;
                const bf16_t* Wsg = AWS + (size_t)(jm * 8 + g) * 16384;
                bf16x8 wsf[4][4];
#pragma unroll
                for (int jt = 0; jt < 4; ++jt)
#pragma unroll
                    for (int ks = 0; ks < 4; ++ks) wsf[jt][ks] = *(const bf16x8*)(Wsg + (size_t)(qbase + jt * 16 + fr) * 128 + ks * 32 + fq * 8);
                float wsr[4], bsr[4];
#pragma unroll
                for (int jt = 0; jt < 4; ++jt) { wsr[jt] = WSROW[(jm * 8 + g) * 128 + qbase + jt * 16 + fr]; bsr[jt] = a_b_s[(jm * 8 + g) * 128 + qbase + jt * 16 + fr]; }
                const int cch = g * 128 + cbase + fq * 8;
                const f32x4 lg0 = *(const f32x4*)(a_ln_g + jm * DM + cch), lg1 = *(const f32x4*)(a_ln_g + jm * DM + cch + 4);
                const f32x4 lb0 = *(const f32x4*)(a_ln_b + jm * DM + cch), lb1 = *(const f32x4*)(a_ln_b + jm * DM + cch + 4);
                LAS bf16_t* vT = (LAS bf16_t*)lds;
                for (int u = blk; u < 4096; u += G) {
                    const int chunk = u >> 3; const size_t tok0 = (size_t)chunk * 128;
#pragma unroll
                    for (int i = 0; i < 4; ++i) {
                        const int ch = tid + 512 * i, prow = ch >> 4, c8 = ch & 15;
                        const u32x4 w = *(const u32x4*)(ZA + (tok0 + prow) * 2048 + 1024 + g * 128 + c8 * 8);
                        f32x2 pt = *(const f32x2*)(STV + (tok0 + prow) * 8 + (tid & 3) * 2);
                        float s = pt.x, q = pt.y;
#pragma unroll
                        for (int o = 1; o < 4; o <<= 1) { s += shx(s, lane, o); q += shx(q, lane, o); }
                        const float mu = s * (1.0f / 1024.0f); const float rstd = __builtin_amdgcn_rsqf(fmaxf(q * (1.0f / 1024.0f) - mu * mu, 0.f) + LN_EPS);
                        const float e0 = (bf_lo(w.x) - mu) * rstd, e1 = (bf_hi(w.x) - mu) * rstd, e2 = (bf_lo(w.y) - mu) * rstd, e3 = (bf_hi(w.y) - mu) * rstd;
                        const float e4 = (bf_lo(w.z) - mu) * rstd, e5 = (bf_hi(w.z) - mu) * rstd, e6 = (bf_lo(w.w) - mu) * rstd, e7 = (bf_hi(w.w) - mu) * rstd;
                        const unsigned p01 = pk2(e0, e1), p23 = pk2(e2, e3), p45 = pk2(e4, e5), p67 = pk2(e6, e7);
                        LAS bf16_t* d = vT + (c8 * 8) * 136 + ((((prow >> 3) ^ c8) << 3) | (prow & 7));
                        d[0 * 136] = (bf16_t)(p01 & 0xffffu); d[1 * 136] = (bf16_t)(p01 >> 16); d[2 * 136] = (bf16_t)(p23 & 0xffffu); d[3 * 136] = (bf16_t)(p23 >> 16);
                        d[4 * 136] = (bf16_t)(p45 & 0xffffu); d[5 * 136] = (bf16_t)(p45 >> 16); d[6 * 136] = (bf16_t)(p67 & 0xffffu); d[7 * 136] = (bf16_t)(p67 >> 16);
                    }
                    __syncthreads();
                    f32x4 acc2[2][4];
#pragma unroll
                    for (int a = 0; a < 2; ++a)
#pragma unroll
                        for (int jt = 0; jt < 4; ++jt) acc2[a][jt] = (f32x4){0.f, 0.f, 0.f, 0.f};
#pragma unroll
                    for (int ks = 0; ks < 4; ++ks) {
#pragma unroll
                        for (int a = 0; a < 2; ++a) {
                            const int crow = cbase + 8 * (fr >> 2) + 4 * a + (fr & 3);
                            const bf16x8 xf = *(const LAS bf16x8*)(vT + crow * 136 + (((ks * 4 + fq) ^ ((crow >> 3) & 15)) << 3));
#pragma unroll
                            for (int jt = 0; jt < 4; ++jt) acc2[a][jt] = __builtin_amdgcn_mfma_f32_16x16x32_bf16(xf, wsf[jt][ks], acc2[a][jt], 0, 0, 0);
                        }
                    }
#pragma unroll
                    for (int jt = 0; jt < 4; ++jt) {
                        const size_t tok = tok0 + qbase + jt * 16 + fr;
                        const u32x4 uw = *(const u32x4*)(ZA + tok * 2048 + cch);
                        const f32x4 m0 = lg0 * acc2[0][jt] + lb0 * wsr[jt] + bsr[jt];
                        const f32x4 m1 = lg1 * acc2[1][jt] + lb1 * wsr[jt] + bsr[jt];
                        u32x4 o; o.x = pk2(bf_lo(uw.x) * m0[0], bf_hi(uw.x) * m0[1]); o.y = pk2(bf_lo(uw.y) * m0[2], bf_hi(uw.y) * m0[3]);
                        o.z = pk2(bf_lo(uw.z) * m1[0], bf_hi(uw.z) * m1[1]); o.w = pk2(bf_lo(uw.w) * m1[2], bf_hi(uw.w) * m1[3]);
                        *(u32x4*)(GA + tok * DM + cch) = o;
                    }
                    __syncthreads();
                }
            }
            GSYNC();
            {
                if (layer == 0) { EpiRes<true, false, false> E{XIN, T2, ST2p, g2p, b2p, nullptr, T1, nullptr, ST1};
                    gemm_phase<0>(lds, wave_id, GA, AWOUT, DM, DM, DM, MT / 256, DM / 256, E); }
                else { EpiRes<false, false, false> E{nullptr, T2, ST2p, g2p, b2p, nullptr, T1, nullptr, ST1};
                    gemm_phase<0>(lds, wave_id, GA, AWOUT + (size_t)jm * DM * DM, DM, DM, DM, MT / 256, DM / 256, E); }
            }
        } else if (kind == 1) {
            bf16_t* ZB = H; bf16_t* PT = H + (size_t)MT * DM; bf16_t* FB = H + (size_t)3 * MT * DM;
            {
                EpiAct<0, 1, true> E{ZB, DM, ST2p, C1MIX + layer * 2048, CBMIX + layer * 2048, STV};
                if (PHMASK & (1u << 2)) gemm_phase<0>(lds, wave_id, T2, BWIN, DM, DM, DM, MT / 256, DM / 256, E);
            }
            GSYNC();
            {
                {
                    FRESH_IDS();
                    const int o0 = gw * 8;
                    if (o0 < 16384) {
                        const int b = o0 >> 10, g = (o0 & 1023) >> 8, l0 = o0 & 255;
                        const size_t tok = (size_t)b * 4096;
                        const f32x2 sa = *(const f32x2*)(STV + tok * 8 + g * 2);
                        const float ssum = sa.x, sq = sa.y;
                        const float mu = ssum * (1.0f / 256.0f), rstd = __builtin_amdgcn_rsqf(fmaxf(sq * (1.0f / 256.0f) - mu * mu, 0.f) + LN_EPS);
                        const u32x2 zw = *(const u32x2*)(ZB + tok * DM + g * 256 + lane * 4);
                        const f32x4 lgv = *(const f32x4*)(b_ln_g + g * 256 + lane * 4), lbv = *(const f32x4*)(b_ln_b + g * 256 + lane * 4);
                        float zn[4] = {(bf_lo(zw.x) - mu) * rstd * lgv[0] + lbv[0], (bf_hi(zw.x) - mu) * rstd * lgv[1] + lbv[1], (bf_lo(zw.y) - mu) * rstd * lgv[2] + lbv[2], (bf_hi(zw.y) - mu) * rstd * lgv[3] + lbv[3]};
#pragma unroll 1
                        for (int t = 0; t < 8; ++t) { const int l = l0 + t; float acc_ = 0.f;
#pragma unroll
                            for (int e = 0; e < 4; ++e) { const int idx = (l * (lane * 4 + e)) & 255; acc_ += zn[e] * cospif((float)idx * (1.0f / 128.0f)); }
                            acc_ = wave_sum(acc_, lane); if (lane == 0) SIDE0[o0 + t] = acc_; }
                    }
                }
                EpiChanDft E{STV, C1CD, C2CD, PT};
                if (PHMASK & (1u << 3)) gemm_phase<1>(lds, wave_id, WCD, ZB, 256, DM, 256, 8, MT / 256, E);
            }
            GSYNC();
            {
                {
                    FRESH_IDS();
                    for (int o = gw; o < 16384; o += NGW) {
                        const bf16_t* pr = PT + (size_t)o * 4096 + lane * 32;
                        float acc_ = 0.f;
#pragma unroll
                        for (int c4 = 0; c4 < 4; ++c4) { const u32x4 w = *(const u32x4*)(pr + c4 * 8);
                            float last = bf_hi(w.w); if (c4 == 3 && lane == 63) last *= 0.5f;
                            acc_ += ((bf_lo(w.x) + bf_hi(w.x)) + (bf_lo(w.y) + bf_hi(w.y))) + ((bf_lo(w.z) + bf_hi(w.z)) + (bf_lo(w.w) + last)); }
                        acc_ = wave_sum(acc_, lane);
                        if (lane == 0) FB[((size_t)(o >> 10) * 4096) * DM + (o & 1023)] = (bf16_t)(pk2((acc_ + SIDE0[o]) * (1.0f / 1024.0f), 0.f) & 0xffffu);
                    }
                }
                EpiDftSym E{FB, SIDE0};
                if (PHMASK & (1u << 4)) gemm_phase<2>(lds, wave_id, DSEQ, PT, 2048, 4096, 2048, 256, 4, E);
            }
            GSYNC();
            {
                EpiRes<false, false, false> E{nullptr, T2, ST2p, g2p, b2p, nullptr, T1, nullptr, ST1};
                if (PHMASK & (1u << 5)) gemm_phase<0>(lds, wave_id, FB, BWOUT, DM, DM, DM, MT / 256, DM / 256, E);
            }
        } else {
            bf16_t* ZC = H; bf16_t* PC = H + (size_t)MT * DM; bf16_t* MC = H + (size_t)2 * MT * DM;
            {
                EpiAct<0, 0, true> E{ZC, DM, ST2p, C1MIX + layer * 2048, CBMIX + layer * 2048, nullptr};
                if (PHMASK & (1u << 6)) gemm_phase<0>(lds, wave_id, T2, CWIN, DM, DM, DM, MT / 256, DM / 256, E);
            }
            GSYNC();
            if (PHMASK & (1u << 22)) {
                FRESH_IDS();
                for (size_t task = gt; task < (size_t)(MT / 32) * 128; task += NGT) {
                    const int co = (int)(task & 127); const size_t seg = task >> 7;
                    const int gidx = co >> 5, w = 2 << gidx, half = w >> 1;
                    const size_t t0 = seg * 32; const int s0 = (int)(t0 & 4095); const size_t bbase = t0 - s0;
                    const bf16_t* zc = ZC + co * 8;
                    float sum[8];
#pragma unroll
                    for (int e = 0; e < 8; ++e) sum[e] = 0.f;
                    const int lo0 = s0 - half < 0 ? 0 : s0 - half, hi0 = s0 + half > SEQ ? SEQ : s0 + half;
                    for (int j = lo0; j < hi0; ++j) { const u32x4 v = *(const u32x4*)(zc + (bbase + j) * DM);
                        sum[0] += bf_lo(v.x); sum[1] += bf_hi(v.x); sum[2] += bf_lo(v.y); sum[3] += bf_hi(v.y); sum[4] += bf_lo(v.z); sum[5] += bf_hi(v.z); sum[6] += bf_lo(v.w); sum[7] += bf_hi(v.w); }
                    for (int i = 0; i < 32; ++i) {
                        const int s = s0 + i; const int lo = s - half < 0 ? 0 : s - half, hi = s + half > SEQ ? SEQ : s + half;
                        const float inv = 1.0f / (float)(hi - lo);
                        const u32x4 zc0 = *(const u32x4*)(zc + (bbase + s) * DM);
                        u32x4 o; o.x = pk2(sum[0] * inv - bf_lo(zc0.x), sum[1] * inv - bf_hi(zc0.x)); o.y = pk2(sum[2] * inv - bf_lo(zc0.y), sum[3] * inv - bf_hi(zc0.y));
                        o.z = pk2(sum[4] * inv - bf_lo(zc0.z), sum[5] * inv - bf_hi(zc0.z)); o.w = pk2(sum[6] * inv - bf_lo(zc0.w), sum[7] * inv - bf_hi(zc0.w));
                        *(u32x4*)(PC + (bbase + s) * DM + co * 8) = o;
                        if (s + half < SEQ) { const u32x4 v = *(const u32x4*)(zc + (bbase + s + half) * DM);
                            sum[0] += bf_lo(v.x); sum[1] += bf_hi(v.x); sum[2] += bf_lo(v.y); sum[3] += bf_hi(v.y); sum[4] += bf_lo(v.z); sum[5] += bf_hi(v.z); sum[6] += bf_lo(v.w); sum[7] += bf_hi(v.w); }
                        if (s - half >= 0) { const u32x4 v = *(const u32x4*)(zc + (bbase + s - half) * DM);
                            sum[0] -= bf_lo(v.x); sum[1] -= bf_hi(v.x); sum[2] -= bf_lo(v.y); sum[3] -= bf_hi(v.y); sum[4] -= bf_lo(v.z); sum[5] -= bf_hi(v.z); sum[6] -= bf_lo(v.w); sum[7] -= bf_hi(v.w); }
                    }
                }
            }
            __syncthreads();
            GSYNC();
            {
                EpiPlain E{MC, c_scale, nullptr};
                if (PHMASK & (1u << 7)) gemm_phase<3>(lds, wave_id, PC, CWG, DM, 256, 256, MT / 256, 4, E);
            }
            GSYNC();
            {
                EpiRes<false, false, false> E{nullptr, T2, ST2p, g2p, b2p, nullptr, T1, nullptr, ST1};
                if (PHMASK & (1u << 8)) gemm_phase<0>(lds, wave_id, MC, CWOUT, DM, DM, DM, MT / 256, DM / 256, E);
            }
        }
        GSYNC();
        constexpr int NCH = FFN_NCH, CHR = MT / NCH;
#define FFN1_CHUNK(ck_) do { const size_t r1 = (size_t)(ck_) * CHR; \
            EpiAct<2, 0, true> E1{H + (size_t)((ck_) & 1) * CHR * FF, FF, ST1 + r1 * 8, C1FFN + layer * FF, CBFFN + layer * FF, nullptr}; \
            gemm_phase<0>(lds, wave_id, T1 + r1 * DM, W1T + (size_t)layer * DM * FF, DM, DM, DM, CHR / 256, FF / 256, E1); } while (0)
        FFN1_CHUNK(0);
        GSYNC();
#pragma unroll 1
        for (int ck = 0; ck < NCH; ++ck) {
            const size_t r0 = (size_t)ck * CHR;
            const bf16_t* Hc = H + (size_t)(ck & 1) * CHR * FF;
            if (layer == 3) { EpiFinal E{T1 + r0 * DM, ST1 + r0 * 8, ln1_g + layer * DM, ln1_b + layer * DM, ffn_b2 + layer * DM, ln2_g + 3 * DM, ln2_b + 3 * DM, p.out + r0 * DM,
                                         (unsigned long long*)(WSP + WS_XBUF) + r0 * 4, (unsigned*)(WSP + WS_CNT) + (size_t)ck * (CHR / 256) * 64};
                gemm_phase<0>(lds, wave_id, Hc, W2T + (size_t)layer * DM * FF, FF, FF, FF, CHR / 256, DM / 256, E); }
            else { EpiRes<false, true, false> E{nullptr, T1 + r0 * DM, ST1 + r0 * 8, ln1_g + layer * DM, ln1_b + layer * DM, ffn_b2 + layer * DM, T2 + r0 * DM, nullptr, ST2 + r0 * 8};
                gemm_phase<0>(lds, wave_id, Hc, W2T + (size_t)layer * DM * FF, FF, FF, FF, CHR / 256, DM / 256, E); }
            if (ck < NCH - 1) FFN1_CHUNK(ck + 1);
            GSYNC();
        }
#undef FFN1_CHUNK
    }
}

extern "C" void kernel_launch(void* const* d_in, const int* in_sizes, int n_in, void* d_out, int out_size, void* d_ws, size_t ws_size, hipStream_t stream) {
    static int grid = 0;
    if (grid == 0) {
        int dev = 0, cus = 0, per_cu = 0;
        hipGetDevice(&dev);
        hipDeviceGetAttribute(&cus, hipDeviceAttributeMultiprocessorCount, dev);
        if (hipFuncSetAttribute((const void*)fwd_megakernel, hipFuncAttributeMaxDynamicSharedMemorySize, LDS_BYTES) != hipSuccess) { fprintf(stderr, "hipFuncSetAttribute failed\n"); grid = -1; return; }
        hipOccupancyMaxActiveBlocksPerMultiprocessor(&per_cu, (const void*)fwd_megakernel, NTHREADS, LDS_BYTES);
        if (per_cu < 1) { fprintf(stderr, "occupancy query says %d blocks per CU\n", per_cu); per_cu = 1; }
        grid = cus * 1;
        if (grid > 1024) grid = 1024;
        grid &= ~7;
        if (ws_size < WS_END) { fprintf(stderr, "workspace too small: %zu < %zu\n", ws_size, (size_t)WS_END); grid = -1; return; }
        (void)hipGetLastError();
    }
    if (grid < 0) return;
    (void)hipMemsetAsync((unsigned char*)d_ws + WS_BAR, 0, 16384 + 65536, stream);
    Params p{};
    for (int i = 0; i < 23; ++i) p.in[i] = (const float*)d_in[i];
    p.out = (float*)d_out; p.ws = (unsigned char*)d_ws; p.coop = 1; p.pad = 0;
    void* args[] = {&p};
    hipError_t e = hipLaunchCooperativeKernel((const void*)fwd_megakernel, dim3(grid), dim3(NTHREADS), args, LDS_BYTES, stream);
    if (e != hipSuccess) fprintf(stderr, "cooperative launch failed: %s (grid %d)\n", hipGetErrorString(e), grid);
}
```
